# Optimizing an MI355X kernel written in HIP

```python
import math
import jax, jax.numpy as jnp
from jax import lax
import numpy as np

D_MODEL = 1024
BATCH = 1
SEQ = 16384
DEPTH = 1
DEC_BATCH = 16
DEC_SEQ = 2048
PAST_LEN = 128

HEAD_DIM_A = 64
V_DIM_A = 2 * HEAD_DIM_A
N_HEADS_A = D_MODEL // V_DIM_A
D_A = N_HEADS_A * V_DIM_A
QK_A = N_HEADS_A * 2 * HEAD_DIM_A
Q_BLOCK = 128
N_HEADS_B = 4
DK_B = D_MODEL // 2
DV_B = D_MODEL
KEY_DIM_B = DK_B // N_HEADS_B
V_DIM_B = DV_B // N_HEADS_B
GATE_RANK = 16
GATE_NORM = 16.0
CHUNK = 64
N_BUCKETS = 32
MAX_DISTANCE = 128
D_FF = 4 * D_MODEL
EPS = 1e-6

IN_SPLIT = [QK_A, QK_A, D_A, DK_B, DK_B, DV_B, DV_B, GATE_RANK, GATE_RANK, D_MODEL, D_MODEL]
IN_OFFSETS = [int(v) for v in np.cumsum(IN_SPLIT)[:-1]]
D_IN = int(sum(IN_SPLIT))

kernel_name = "hybrid_diffattn_gla_encoder"


def rms_norm(x, g):
    xf = x.astype(jnp.float32)
    y = xf * lax.rsqrt(jnp.mean(xf * xf, axis=-1, keepdims=True) + EPS)
    return (y * g.astype(jnp.float32)).astype(x.dtype)


def t5_bucket(rel):
    nb = N_BUCKETS // 2
    max_exact = nb // 2
    ret = (rel > 0).astype(jnp.int32) * nb
    n = jnp.abs(rel)
    nf = jnp.maximum(n, 1).astype(jnp.float32)
    large = max_exact + (jnp.log(nf / max_exact) / math.log(MAX_DISTANCE / max_exact)
                         * (nb - max_exact)).astype(jnp.int32)
    large = jnp.minimum(large, nb - 1)
    return ret + jnp.where(n < max_exact, n, large)


def diff_attention(q, k, v, lam, rel_bias):
    B, S = q.shape[0], q.shape[1]
    nblk = S // Q_BLOCK
    scale = HEAD_DIM_A ** -0.5
    qb = q.reshape(B, nblk, Q_BLOCK, N_HEADS_A, 2, HEAD_DIM_A).transpose(1, 0, 2, 3, 4, 5)
    kpos = jnp.arange(S, dtype=jnp.int32)
    vf = v.astype(jnp.float32)

    def one_block(args):
        q_blk, i = args
        qpos = i * Q_BLOCK + jnp.arange(Q_BLOCK, dtype=jnp.int32)
        bias = rel_bias[t5_bucket(kpos[None, :] - qpos[:, None])]
        bias = bias.transpose(2, 0, 1).astype(jnp.float32)
        s = jnp.einsum('bqhmd,bkhmd->bmhqk', q_blk, k).astype(jnp.float32) * scale + bias
        p = jax.nn.softmax(s, axis=-1)
        w = p[:, 0] - lam * p[:, 1]
        return jnp.einsum('bhqk,bkhd->bqhd', w, vf)

    o = lax.map(one_block, (qb, jnp.arange(nblk, dtype=jnp.int32)))
    return o.transpose(1, 0, 2, 3, 4).reshape(B, S, N_HEADS_A, V_DIM_A)


def gla_scan(q, k, v, g):
    B, S, H, dk = q.shape
    dv = v.shape[-1]
    nc = S // CHUNK

    def to_chunks(t):
        return t.reshape(B, nc, CHUNK, H, t.shape[-1]).transpose(1, 0, 3, 2, 4)

    mask = jnp.tril(jnp.ones((CHUNK, CHUNK), dtype=bool))[:, :, None]

    def step(state, inp):
        qc, kc, vc, gc = inp
        b = jnp.cumsum(gc, axis=2)
        o_inter = jnp.einsum('bhcd,bhde->bhce', qc * jnp.exp(b), state)
        diff = b[:, :, :, None, :] - b[:, :, None, :, :]
        decay = jnp.where(mask, jnp.exp(jnp.minimum(diff, 0.0)), 0.0)
        a = jnp.einsum('bhid,bhjd,bhijd->bhij', qc, kc, decay)
        o = o_inter + jnp.einsum('bhij,bhje->bhie', a, vc)
        b_last = b[:, :, -1:, :]
        state = (jnp.exp(b_last[:, :, 0, :, None]) * state
                 + jnp.einsum('bhjd,bhje->bhde', kc * jnp.exp(b_last - b), vc))
        return state, o

    s0 = jnp.zeros((B, H, dk, dv), jnp.float32)
    _, o = lax.scan(step, s0, (to_chunks(q), to_chunks(k), to_chunks(v), to_chunks(g)))
    return o.transpose(1, 0, 3, 2, 4).reshape(B, S, H, dv)


def bidirectional_gla(q, k, v, g_fwd, g_bwd):
    o_f = gla_scan(q, k, v, g_fwd)
    flip = lambda t: jnp.flip(t, axis=1)
    o_b = flip(gla_scan(flip(q), flip(k), flip(v), flip(g_bwd)))
    return o_f + o_b


def encoder_layer(x, c, layer_idx, rel_bias, w_ada, b_ada, norm1_g, w_in, q_norm_g, k_norm_g,
                  lam_q1, lam_k1, lam_q2, lam_k2, subln_g, w_gate_f, b_gate_f, w_gate_b, b_gate_b,
                  gla_norm_g, w_branch_a, w_branch_b, w_out, norm2_g, w_up, w_down):
    B, S, _ = x.shape
    mod = jax.nn.silu(c) @ w_ada + b_ada
    shift1, scale1, gate1, shift2, scale2, gate2 = jnp.split(mod, 6, axis=-1)

    h = rms_norm(x, norm1_g) * (1.0 + scale1[:, None]) + shift1[:, None]
    proj = h @ w_in
    qa, ka, va, qg, kg, vg, og, lr_f, lr_b, ga, gb = jnp.split(proj, IN_OFFSETS, axis=-1)

    lambda_init = 0.8 - 0.6 * math.exp(-0.3 * layer_idx)
    lam = (jnp.exp(jnp.sum(lam_q1.astype(jnp.float32) * lam_k1.astype(jnp.float32)))
           - jnp.exp(jnp.sum(lam_q2.astype(jnp.float32) * lam_k2.astype(jnp.float32))) + lambda_init)
    qa = rms_norm(qa.reshape(B, S, N_HEADS_A, 2, HEAD_DIM_A), q_norm_g)
    ka = rms_norm(ka.reshape(B, S, N_HEADS_A, 2, HEAD_DIM_A), k_norm_g)
    oa = diff_attention(qa, ka, va.reshape(B, S, N_HEADS_A, V_DIM_A), lam, rel_bias)
    oa = (rms_norm(oa, subln_g) * (1.0 - lambda_init)).astype(x.dtype)
    ya = oa.reshape(B, S, D_A) @ w_branch_a

    f32 = jnp.float32
    g_f = jax.nn.log_sigmoid((lr_f @ w_gate_f + b_gate_f).astype(f32)) / GATE_NORM
    g_b = jax.nn.log_sigmoid((lr_b @ w_gate_b + b_gate_b).astype(f32)) / GATE_NORM
    hk = lambda t: t.reshape(B, S, N_HEADS_B, KEY_DIM_B)
    ob = bidirectional_gla(hk(qg.astype(f32)) * KEY_DIM_B ** -0.5, hk(kg.astype(f32)),
                           vg.astype(f32).reshape(B, S, N_HEADS_B, V_DIM_B), hk(g_f), hk(g_b))
    ob = rms_norm(ob, gla_norm_g) * jax.nn.silu(og.astype(f32)).reshape(B, S, N_HEADS_B, V_DIM_B)
    yb = ob.astype(x.dtype).reshape(B, S, DV_B) @ w_branch_b

    merged = jax.nn.sigmoid(ga) * ya + jax.nn.sigmoid(gb) * yb
    x = x + gate1[:, None] * (merged @ w_out)

    h2 = rms_norm(x, norm2_g) * (1.0 + scale2[:, None]) + shift2[:, None]
    u = jax.nn.relu(h2 @ w_up)
    x = x + gate2[:, None] * ((u * u) @ w_down)
    return x


def setup_inputs(seed: int = 0) -> dict:
    key = jax.random.key(seed)
    ks = jax.random.split(key, 32)
    nrm = lambda k, shape, s: jax.random.normal(k, shape, jnp.float32) * s
    L = DEPTH
    return {
        "x_prompt": nrm(ks[0], (BATCH, SEQ, D_MODEL), 1.0),
        "x_sample": nrm(ks[1], (DEC_BATCH, DEC_SEQ, D_MODEL), 1.0),
        "c_prompt": nrm(ks[2], (BATCH, D_MODEL), 1.0),
        "c_sample": nrm(ks[3], (DEC_BATCH, D_MODEL), 1.0),
        "rel_bias": nrm(ks[4], (N_BUCKETS, N_HEADS_A), 0.5),
        "w_ada": nrm(ks[5], (L, D_MODEL, 6 * D_MODEL), 0.2 * D_MODEL ** -0.5),
        "b_ada": nrm(ks[6], (L, 6 * D_MODEL), 0.02),
        "norm1_g": 1.0 + nrm(ks[7], (L, D_MODEL), 0.02),
        "w_in": nrm(ks[8], (L, D_MODEL, D_IN), D_MODEL ** -0.5),
        "q_norm_g": 1.0 + nrm(ks[9], (L, HEAD_DIM_A), 0.02),
        "k_norm_g": 1.0 + nrm(ks[10], (L, HEAD_DIM_A), 0.02),
        "lam_q1": nrm(ks[11], (L, HEAD_DIM_A), 0.1),
        "lam_k1": nrm(ks[12], (L, HEAD_DIM_A), 0.1),
        "lam_q2": nrm(ks[13], (L, HEAD_DIM_A), 0.1),
        "lam_k2": nrm(ks[14], (L, HEAD_DIM_A), 0.1),
        "subln_g": 1.0 + nrm(ks[15], (L, V_DIM_A), 0.02),
        "w_gate_f": nrm(ks[16], (L, GATE_RANK, DK_B), GATE_RANK ** -0.5),
        "b_gate_f": nrm(ks[17], (L, DK_B), 0.1),
        "w_gate_b": nrm(ks[18], (L, GATE_RANK, DK_B), GATE_RANK ** -0.5),
        "b_gate_b": nrm(ks[19], (L, DK_B), 0.1),
        "gla_norm_g": 1.0 + nrm(ks[20], (L, V_DIM_B), 0.02),
        "w_branch_a": nrm(ks[21], (L, D_A, D_MODEL), D_A ** -0.5),
        "w_branch_b": nrm(ks[22], (L, DV_B, D_MODEL), DV_B ** -0.5),
        "w_out": nrm(ks[23], (L, D_MODEL, D_MODEL), D_MODEL ** -0.5),
        "norm2_g": 1.0 + nrm(ks[24], (L, D_MODEL), 0.02),
        "w_up": nrm(ks[25], (L, D_MODEL, D_FF), D_MODEL ** -0.5),
        "w_down": nrm(ks[26], (L, D_FF, D_MODEL), D_FF ** -0.5),
    }


def reference(x_prompt, x_sample, c_prompt, c_sample, rel_bias, w_ada, b_ada, norm1_g, w_in,
              q_norm_g, k_norm_g, lam_q1, lam_k1, lam_q2, lam_k2, subln_g, w_gate_f, b_gate_f,
              w_gate_b, b_gate_b, gla_norm_g, w_branch_a, w_branch_b, w_out, norm2_g, w_up, w_down):
    def run_trunk(x, c):
        for l in range(DEPTH):
            x = encoder_layer(x, c, l, rel_bias, w_ada[l], b_ada[l], norm1_g[l], w_in[l],
                              q_norm_g[l], k_norm_g[l], lam_q1[l], lam_k1[l], lam_q2[l], lam_k2[l],
                              subln_g[l], w_gate_f[l], b_gate_f[l], w_gate_b[l], b_gate_b[l],
                              gla_norm_g[l], w_branch_a[l], w_branch_b[l], w_out[l], norm2_g[l],
                              w_up[l], w_down[l])
        return x

    y_prompt = run_trunk(x_prompt, c_prompt)
    y_sample = run_trunk(x_sample, c_sample)
    return (y_prompt, y_sample)
```

```cpp
#include <hip/hip_runtime.h>
#include <hip/hip_cooperative_groups.h>
#include <cstdint>
#include <cstdio>
namespace cg = cooperative_groups;

#ifndef ONE_LAUNCH
#define ONE_LAUNCH 0
#endif

#define DI __device__ __forceinline__
typedef unsigned short bf16_t;
typedef short bf16x8 __attribute__((ext_vector_type(8)));
typedef float f32x16 __attribute__((ext_vector_type(16)));
typedef float f32x4 __attribute__((ext_vector_type(4)));
typedef float f32x2 __attribute__((ext_vector_type(2)));
typedef unsigned u32x4 __attribute__((ext_vector_type(4)));
typedef unsigned u32x2 __attribute__((ext_vector_type(2)));
typedef __bf16 bf16v2 __attribute__((ext_vector_type(2)));
#define OPAQUE(x) asm volatile("" : "+v"(x))
#define MFMA32(a, b, c) __builtin_amdgcn_mfma_f32_32x32x16_bf16((a), (b), (c), 0, 0, 0)

constexpr int TOKG = 16384;
constexpr int NPROJ = 6144;
constexpr float EPSN = 1e-6f;
constexpr float LOG2E = 1.4426950408889634f;
constexpr float QSCALE = 0.125f * LOG2E;

constexpr size_t MiB = 1024 * 1024;
constexpr size_t OFF_WIN = 0;
constexpr size_t OFF_WA = OFF_WIN + (size_t)8320 * 1024 * 2;
constexpr size_t OFF_WB = OFF_WA + 2 * MiB;
constexpr size_t OFF_WO = OFF_WB + 2 * MiB;
constexpr size_t OFF_WUP = OFF_WO + 2 * MiB;
constexpr size_t OFF_WDN = OFF_WUP + 8 * MiB;
constexpr size_t OFF_MOD = OFF_WDN + 8 * MiB;
constexpr size_t OFF_MISC = OFF_MOD + 512 * 1024;
constexpr size_t OFF_H = OFF_MISC + 4096;
constexpr size_t OFF_PROJ = OFF_H + 32 * MiB;
constexpr size_t OFF_VAT = OFF_PROJ + 192 * MiB;
constexpr size_t OFF_VGT = OFF_VAT + 32 * MiB;
constexpr size_t OFF_LR = OFF_VGT + 32 * MiB;
constexpr size_t OFF_GQ = OFF_LR + 2 * MiB;
constexpr size_t OFF_GK = OFF_GQ + 32 * MiB;
constexpr size_t OFF_GKT = OFF_GK + 32 * MiB;
constexpr size_t OFF_GE = OFF_GKT + 32 * MiB;
constexpr size_t OFF_OA = OFF_GE + 1 * MiB;
constexpr size_t WS_TOTAL = OFF_OA + 32 * MiB;

struct Params {
  const float *x_prompt, *x_sample, *c_prompt, *c_sample, *rel_bias, *w_ada, *b_ada, *norm1_g, *w_in, *q_norm_g, *k_norm_g,
      *lam_q1, *lam_k1, *lam_q2, *lam_k2, *subln_g, *w_gate_f, *b_gate_f, *w_gate_b, *b_gate_b, *gla_norm_g, *w_branch_a,
      *w_branch_b, *w_out, *norm2_g, *w_up, *w_down;
  float* out;
  char* ws;
};

DI float bf2f(bf16_t v) { return __uint_as_float(((unsigned)v) << 16); }
DI unsigned pk_bf16(float lo, float hi) { f32x2 v = {lo, hi}; bf16v2 b = __builtin_convertvector(v, bf16v2); return __builtin_bit_cast(unsigned, b); }
DI bf16_t f2bf(float x) { return (bf16_t)(pk_bf16(x, 0.f) & 0xffffu); }
DI int crow(int r, int h) { return (r & 3) + 8 * (r >> 2) + 4 * h; }
DI float sigmoidf_(float x) { return 1.f / (1.f + __expf(-x)); }
DI int permpos(int t) { return (t & ~12) | ((t & 4) << 1) | ((t & 8) >> 1); }
DI float half_sum32(float v) {
  v += __shfl_xor(v, 1); v += __shfl_xor(v, 2); v += __shfl_xor(v, 4); v += __shfl_xor(v, 8); v += __shfl_xor(v, 16); return v;
}
DI void zero_acc(f32x16 (&acc)[2][2]) {
#pragma unroll
  for (int a = 0; a < 2; ++a)
#pragma unroll
    for (int b = 0; b < 2; ++b)
#pragma unroll
      for (int r = 0; r < 16; ++r) acc[a][b][r] = 0.f;
}

struct GroupInfo { int S, nseq, b0; const float* x; float* out; };
DI GroupInfo group_info(const Params& p, int g) {
  GroupInfo gi;
  if (g == 0) { gi.S = 16384; gi.nseq = 1; gi.b0 = 0; gi.x = p.x_prompt; }
  else { gi.S = 2048; gi.nseq = 8; gi.b0 = 1 + (g - 1) * 8; gi.x = p.x_sample + (size_t)(g - 1) * TOKG * 1024; }
  gi.out = p.out + (size_t)g * TOKG * 1024;
  return gi;
}
DI int row_batch(const GroupInfo& gi, int row) { return gi.b0 + (gi.nseq == 1 ? 0 : (row >> 11)); }

template <bool SWAP>
DI void gemm_tile(const bf16_t* __restrict__ A, int lda, const bf16_t* __restrict__ Bt, int ldb, int K, f32x16 (&acc)[2][2], bf16_t* As, bf16_t* Bs) {
  const int tid = threadIdx.x, lane = tid & 63, wave = tid >> 6, wm = wave >> 1, wn = wave & 1;
  const int lr = tid >> 3, lc = (tid & 7) * 8;
  const bf16_t* ga = A + (size_t)lr * lda + lc;
  const bf16_t* gb = Bt + (size_t)lr * ldb + lc;
  u32x4 ra[4], rb[4];
#pragma unroll
  for (int i = 0; i < 4; ++i) { ra[i] = *(const u32x4*)(ga + (size_t)(32 * i) * lda); rb[i] = *(const u32x4*)(gb + (size_t)(32 * i) * ldb); }
  const int fr = lane & 31, fk = (lane >> 5) * 8;
  const bf16_t* pa = As + (wm * 64 + fr) * 72 + fk;
  const bf16_t* pb = Bs + (wn * 64 + fr) * 72 + fk;
  for (int k0 = 0; k0 < K; k0 += 64) {
    __syncthreads();
#pragma unroll
    for (int i = 0; i < 4; ++i) { *(u32x4*)(As + (lr + 32 * i) * 72 + lc) = ra[i]; *(u32x4*)(Bs + (lr + 32 * i) * 72 + lc) = rb[i]; }
    __syncthreads();
    if (k0 + 64 < K) {
#pragma unroll
      for (int i = 0; i < 4; ++i) { ra[i] = *(const u32x4*)(ga + (size_t)(32 * i) * lda + k0 + 64); rb[i] = *(const u32x4*)(gb + (size_t)(32 * i) * ldb + k0 + 64); }
    }
#pragma unroll
    for (int s = 0; s < 4; ++s) {
      const bf16x8 a0 = *(const bf16x8*)(pa + s * 16), a1 = *(const bf16x8*)(pa + 32 * 72 + s * 16);
      const bf16x8 b0 = *(const bf16x8*)(pb + s * 16), b1 = *(const bf16x8*)(pb + 32 * 72 + s * 16);
      if (SWAP) {
        acc[0][0] = MFMA32(b0, a0, acc[0][0]); acc[0][1] = MFMA32(b1, a0, acc[0][1]);
        acc[1][0] = MFMA32(b0, a1, acc[1][0]); acc[1][1] = MFMA32(b1, a1, acc[1][1]);
      } else {
        acc[0][0] = MFMA32(a0, b0, acc[0][0]); acc[0][1] = MFMA32(a0, b1, acc[0][1]);
        acc[1][0] = MFMA32(a1, b0, acc[1][0]); acc[1][1] = MFMA32(a1, b1, acc[1][1]);
      }
    }
  }
}

struct TileSched {
  int j, step, total, NT, xcd, simple;
  DI TileSched(int bid, int nb, int NT_) {
    NT = NT_;
    if ((nb & 7) == 0) { xcd = bid & 7; j = bid >> 3; step = nb >> 3; total = 16 * NT; simple = 0; }
    else { xcd = 0; j = bid; step = nb; total = 128 * NT; simple = 1; }
  }
  DI bool next(int& mt, int& nt) {
    if (j >= total) return false;
    if (simple) { mt = j & 127; nt = j >> 7; }
    else { const int half = j / (8 * NT), jj = j - half * 8 * NT; mt = xcd * 16 + half * 8 + (jj & 7); nt = jj >> 3; }
    j += step; return true;
  }
};

DI int win_src_col(int n) { return n < 6144 ? n : (n < 8192 ? n + 32 : (n < 8224 ? n - 2048 : -1)); }

DI void transpose_tile(const float* __restrict__ W, int ldw, bf16_t* __restrict__ Wt, int K, int kt, int nt, bool is_win, float* sm) {
  const int tid = threadIdx.x, c = tid & 63, r0 = tid >> 6;
  const int n = nt * 64 + c; const int src = is_win ? win_src_col(n) : n;
  __syncthreads();
#pragma unroll
  for (int i = 0; i < 16; ++i) { const int k = r0 + 4 * i; sm[k * 65 + c] = (src >= 0) ? W[(size_t)(kt * 64 + k) * ldw + src] : 0.f; }
  __syncthreads();
#pragma unroll
  for (int i = 0; i < 16; ++i) { const int nn = r0 + 4 * i; Wt[(size_t)(nt * 64 + nn) * K + kt * 64 + c] = f2bf(sm[c * 65 + nn]); }
}

DI void mod_item(const Params& p, int cgi, char* smem) {
  float* tab = (float*)smem;
  float* red = tab + 17 * 512;
  float* mod = (float*)(p.ws + OFF_MOD);
  const int tid = threadIdx.x, cl = tid & 63, kq = tid >> 6, col = cgi * 64 + cl;
  float acc[17];
#pragma unroll
  for (int b = 0; b < 17; ++b) acc[b] = 0.f;
  for (int pass = 0; pass < 2; ++pass) {
    __syncthreads();
    for (int i = tid; i < 17 * 512; i += 256) {
      const int b = i >> 9, k = pass * 512 + (i & 511);
      const float cv = (b == 0) ? p.c_prompt[k] : p.c_sample[(b - 1) * 1024 + k];
      tab[i] = cv / (1.f + __expf(-cv));
    }
    __syncthreads();
    for (int kk = 0; kk < 128; ++kk) {
      const int k = kq * 128 + kk;
      const float w = p.w_ada[(size_t)(pass * 512 + k) * 6144 + col];
#pragma unroll
      for (int b = 0; b < 17; ++b) acc[b] += tab[b * 512 + k] * w;
    }
  }
  __syncthreads();
#pragma unroll
  for (int b = 0; b < 17; ++b) red[(kq * 17 + b) * 64 + cl] = acc[b];
  __syncthreads();
  for (int i = tid; i < 17 * 64; i += 256) {
    const int b = i >> 6, c = i & 63;
    const float s = red[(0 * 17 + b) * 64 + c] + red[(1 * 17 + b) * 64 + c] + red[(2 * 17 + b) * 64 + c] + red[(3 * 17 + b) * 64 + c];
    mod[b * 6144 + cgi * 64 + c] = s + p.b_ada[cgi * 64 + c];
  }
}

DI void phase_prologue(const Params& p, char* smem, int bid, int nb) {
  constexpr int N0 = 96, N1 = N0 + 2080, N2 = N1 + 256, N3 = N2 + 256, N4 = N3 + 256, N5 = N4 + 1024, N6 = N5 + 1024;
  for (int it = bid; it < N6 + 1; it += nb) {
    if (it < N0) mod_item(p, it, smem);
    else if (it < N1) { const int t = it - N0; transpose_tile(p.w_in, 8224, (bf16_t*)(p.ws + OFF_WIN), 1024, t & 15, t >> 4, true, (float*)smem); }
    else if (it < N2) { const int t = it - N1; transpose_tile(p.w_branch_a, 1024, (bf16_t*)(p.ws + OFF_WA), 1024, t & 15, t >> 4, false, (float*)smem); }
    else if (it < N3) { const int t = it - N2; transpose_tile(p.w_branch_b, 1024, (bf16_t*)(p.ws + OFF_WB), 1024, t & 15, t >> 4, false, (float*)smem); }
    else if (it < N4) { const int t = it - N3; transpose_tile(p.w_out, 1024, (bf16_t*)(p.ws + OFF_WO), 1024, t & 15, t >> 4, false, (float*)smem); }
    else if (it < N5) { const int t = it - N4; transpose_tile(p.w_up, 4096, (bf16_t*)(p.ws + OFF_WUP), 1024, t & 15, t >> 4, false, (float*)smem); }
    else if (it < N6) { const int t = it - N5; transpose_tile(p.w_down, 1024, (bf16_t*)(p.ws + OFF_WDN), 4096, t & 63, t >> 6, false, (float*)smem); }
    else {
      int* ctr = (int*)(p.ws + OFF_MISC);
      if (threadIdx.x < 4) ctr[threadIdx.x] = 0;
      if (threadIdx.x >= 64 && threadIdx.x < 128) {
        const int l = threadIdx.x - 64;
        float a = p.lam_q1[l] * p.lam_k1[l], b = p.lam_q2[l] * p.lam_k2[l];
#pragma unroll
        for (int m = 32; m >= 1; m >>= 1) { a += __shfl_xor(a, m); b += __shfl_xor(b, m); }
        if (l == 0) *(float*)(p.ws + OFF_MISC + 64) = __expf(a) - __expf(b) + 0.2f;
      }
    }
  }
}

DI void phase_modnorm(const Params& p, int g, const float* xin, const float* gvec, int shift_off, int scale_off, int bid, int nb) {
  const GroupInfo gi = group_info(p, g);
  const float* mod = (const float*)(p.ws + OFF_MOD);
  bf16_t* hout = (bf16_t*)(p.ws + OFF_H);
  const int lane = threadIdx.x & 63, wave = threadIdx.x >> 6;
  for (int row = bid * 4 + wave; row < TOKG; row += nb * 4) {
    const int b = row_batch(gi, row);
    const float* xr = xin + (size_t)row * 1024;
    f32x4 v[4]; float ss = 0.f;
#pragma unroll
    for (int i = 0; i < 4; ++i) { v[i] = *(const f32x4*)(xr + i * 256 + lane * 4); ss += v[i][0] * v[i][0] + v[i][1] * v[i][1] + v[i][2] * v[i][2] + v[i][3] * v[i][3]; }
#pragma unroll
    for (int m = 32; m >= 1; m >>= 1) ss += __shfl_xor(ss, m);
    const float rs = rsqrtf(ss * (1.f / 1024.f) + EPSN);
#pragma unroll
    for (int i = 0; i < 4; ++i) {
      const int c = i * 256 + lane * 4;
      const f32x4 gv = *(const f32x4*)(gvec + c), sc = *(const f32x4*)(mod + b * 6144 + scale_off + c), sh = *(const f32x4*)(mod + b * 6144 + shift_off + c);
      f32x4 y;
#pragma unroll
      for (int e = 0; e < 4; ++e) y[e] = v[i][e] * rs * gv[e] * (1.f + sc[e]) + sh[e];
      u32x2 o; o.x = pk_bf16(y[0], y[1]); o.y = pk_bf16(y[2], y[3]);
      *(u32x2*)(hout + (size_t)row * 1024 + c) = o;
    }
  }
}

DI void phase_gemm1(const Params& p, int g, char* smem, int bid, int nb) {
  bf16_t* As = (bf16_t*)smem; bf16_t* Bs = As + 128 * 72;
  const bf16_t* H = (const bf16_t*)(p.ws + OFF_H); const bf16_t* W = (const bf16_t*)(p.ws + OFF_WIN);
  bf16_t* proj = (bf16_t*)(p.ws + OFF_PROJ); bf16_t* vaT = (bf16_t*)(p.ws + OFF_VAT); bf16_t* vgT = (bf16_t*)(p.ws + OFF_VGT);
  float* lrb = (float*)(p.ws + OFF_LR);
  const int lane = threadIdx.x & 63, wave = threadIdx.x >> 6, wm_ = wave >> 1, wn_ = wave & 1, h_ = lane >> 5, l31_ = lane & 31;
  TileSched ts(bid, nb, 65);
  int mt, nt;
  while (ts.next(mt, nt)) {
    f32x16 acc[2][2]; zero_acc(acc);
    const bool swp = (nt >= 16 && nt < 24) || (nt >= 32 && nt < 40);
    const bf16_t* A = H + (size_t)mt * 128 * 1024; const bf16_t* B = W + (size_t)nt * 128 * 1024;
    if (swp) gemm_tile<true>(A, 1024, B, 1024, 1024, acc, As, Bs); else gemm_tile<false>(A, 1024, B, 1024, 1024, acc, As, Bs);
    int wm = wm_, wn = wn_, h = h_, l31 = l31_; OPAQUE(wm); OPAQUE(wn); OPAQUE(h); OPAQUE(l31);
    const int row0 = mt * 128;
    bf16_t* projt = proj + (size_t)row0 * NPROJ;
    if (nt < 16) {
      const float* gn = (nt < 8) ? p.q_norm_g : p.k_norm_g; const float sc = (nt < 8) ? QSCALE : 1.f;
      const float g0 = gn[l31] * sc, g1 = gn[32 + l31] * sc;
#pragma unroll
      for (int mi = 0; mi < 2; ++mi)
#pragma unroll
        for (int r = 0; r < 16; ++r) {
          const float a0 = acc[mi][0][r], a1 = acc[mi][1][r];
          const float ss = half_sum32(a0 * a0 + a1 * a1);
          const float rs = rsqrtf(ss * (1.f / 64.f) + EPSN);
          bf16_t* dst = projt + (wm * 64 + mi * 32 + crow(r, h)) * NPROJ + nt * 128 + wn * 64 + l31;
          dst[0] = f2bf(a0 * rs * g0); dst[32] = f2bf(a1 * rs * g1);
        }
    } else if (nt < 24) {
#pragma unroll
      for (int mi = 0; mi < 2; ++mi) {
        const int pp = permpos(row0 + wm * 64 + mi * 32 + l31);
#pragma unroll
        for (int ni = 0; ni < 2; ++ni)
#pragma unroll
          for (int r = 0; r < 16; ++r) { const int n = (nt - 16) * 128 + wn * 64 + ni * 32 + crow(r, h); vaT[(size_t)n * TOKG + pp] = f2bf(acc[mi][ni][r]); }
      }
    } else if (nt < 40 && nt >= 32) {
#pragma unroll
      for (int mi = 0; mi < 2; ++mi) {
        const int tok = row0 + wm * 64 + mi * 32 + l31, chunk = tok >> 6, tk = tok & 63;
#pragma unroll
        for (int ni = 0; ni < 2; ++ni)
#pragma unroll
          for (int r = 0; r < 16; ++r) {
            const int n = (nt - 32) * 128 + wn * 64 + ni * 32 + crow(r, h); const int hd = n >> 8, dv = n & 255;
            vgT[((size_t)(hd * 256 + chunk) * 256 + dv) * 64 + tk] = f2bf(acc[mi][ni][r]);
          }
      }
    } else if (nt < 64) {
      const int coff = (nt < 32) ? nt * 128 - 1024 : nt * 128 - 2048;
      const int mode = (nt < 32) ? 0 : (nt < 48 ? 1 : 2);
#pragma unroll
      for (int mi = 0; mi < 2; ++mi)
#pragma unroll
        for (int ni = 0; ni < 2; ++ni)
#pragma unroll
          for (int r = 0; r < 16; ++r) {
            float v = acc[mi][ni][r];
            if (mode == 1) v = v * sigmoidf_(v); else if (mode == 2) v = sigmoidf_(v);
            projt[(wm * 64 + mi * 32 + crow(r, h)) * NPROJ + coff + wn * 64 + ni * 32 + l31] = f2bf(v);
          }
    } else {
      if (wn == 0) {
#pragma unroll
        for (int mi = 0; mi < 2; ++mi)
#pragma unroll
          for (int r = 0; r < 16; ++r) (lrb + (size_t)row0 * 32)[(wm * 64 + mi * 32 + crow(r, h)) * 32 + l31] = acc[mi][0][r];
      }
    }
  }
}

DI float logsig16(float z) { return (fminf(z, 0.f) - __logf(1.f + __expf(-fabsf(z)))) * (1.f / 16.f); }

DI void phase_gla_prep(const Params& p, int g, char* smem, int bid, int nb) {
  float* lrs = (float*)smem;
  float* tot = lrs + 1024;
  const bf16_t* proj = (const bf16_t*)(p.ws + OFF_PROJ); const float* lrb = (const float*)(p.ws + OFF_LR);
  bf16_t* gq = (bf16_t*)(p.ws + OFF_GQ); bf16_t* gk = (bf16_t*)(p.ws + OFF_GK); bf16_t* gkt = (bf16_t*)(p.ws + OFF_GKT); float* ge = (float*)(p.ws + OFF_GE);
  const int tid = threadIdx.x, d = tid & 127, half = tid >> 7;
  for (int item = bid; item < 2048; item += nb) {
    const int c = item & 255, head = (item >> 8) & 3, dir = item >> 10, dd = head * 128 + d;
    __syncthreads();
#pragma unroll
    for (int i = 0; i < 4; ++i) { const int idx = tid + 256 * i; lrs[idx] = lrb[(size_t)(c * 64 + (idx >> 4)) * 32 + dir * 16 + (idx & 15)]; }
    const float* wgp = dir ? p.w_gate_b : p.w_gate_f;
    float wg[16];
#pragma unroll
    for (int r = 0; r < 16; ++r) wg[r] = wgp[r * 512 + dd];
    const float bg = (dir ? p.b_gate_b : p.b_gate_f)[dd];
    __syncthreads();
    float tsum = 0.f;
    for (int tt = 0; tt < 32; ++tt) {
      const float* l = lrs + (half * 32 + tt) * 16; float z = bg;
#pragma unroll
      for (int r = 0; r < 16; ++r) z += l[r] * wg[r];
      tsum += logsig16(z);
    }
    tot[half * 128 + d] = tsum;
    __syncthreads();
    const float t0 = tot[d], t1 = tot[128 + d], TOTAL = t0 + t1;
    float run = half ? t0 : 0.f;
    const size_t blk = (size_t)((dir * 4 + head) * 256 + c);
    unsigned ktp[16];
#pragma unroll
    for (int tt = 0; tt < 32; ++tt) {
      const int t = half * 32 + tt;
      const float* l = lrs + t * 16; float z = bg;
#pragma unroll
      for (int r = 0; r < 16; ++r) z += l[r] * wg[r];
      const float gv = logsig16(z);
      const float b = dir ? (TOTAL - run) : (run + gv);
      run += gv;
      const size_t tg = (size_t)c * 64 + t;
      const float qv = bf2f(proj[tg * NPROJ + 2048 + dd]), kv = bf2f(proj[tg * NPROJ + 2560 + dd]);
      const float qt = qv * __expf(b) * 0.08838834764831845f, kt = kv * __expf(-b);
      gq[(blk * 64 + t) * 128 + d] = f2bf(qt);
      const bf16_t kb = f2bf(kt);
      gk[(blk * 64 + t) * 128 + d] = kb;
      if (tt & 1) ktp[tt >> 1] |= ((unsigned)kb) << 16; else ktp[tt >> 1] = kb;
    }
    bf16_t* kd = gkt + (blk * 128 + d) * 64 + half * 32;
#pragma unroll
    for (int q = 0; q < 4; ++q) { u32x4 v = {ktp[4 * q], ktp[4 * q + 1], ktp[4 * q + 2], ktp[4 * q + 3]}; *(u32x4*)(kd + 8 * q) = v; }
    if (half == 0) ge[blk * 128 + d] = __expf(TOTAL);
  }
}

DI void gla_scan_unit(const Params& p, int g, int u, char* smem) {
  const GroupInfo gi = group_info(p, g);
  bf16_t* St = (bf16_t*)smem;
  bf16_t* Am = St + 64 * 136;
  const int slice = u & 3, dir = (u >> 2) & 1, head = (u >> 3) & 3, seq = u >> 5;
  const int nchunk = gi.S >> 6, chunk0 = seq * nchunk;
  const int tid = threadIdx.x, lane = tid & 63, wave = tid >> 6, wi = wave >> 1, wd = wave & 1, h = lane >> 5, l31 = lane & 31;
  const bf16_t* gq = (const bf16_t*)(p.ws + OFF_GQ); const bf16_t* gk = (const bf16_t*)(p.ws + OFF_GK); const bf16_t* gkt = (const bf16_t*)(p.ws + OFF_GKT);
  const float* ge = (const float*)(p.ws + OFF_GE); const bf16_t* vgT = (const bf16_t*)(p.ws + OFF_VGT);
  bf16_t* od = (bf16_t*)gi.out + (size_t)dir * TOKG * 1024;
  __syncthreads();
  for (int i = tid; i < 64 * 136 / 2; i += 256) ((unsigned*)St)[i] = 0u;
  f32x16 Sacc[2];
#pragma unroll
  for (int t = 0; t < 2; ++t)
#pragma unroll
    for (int r = 0; r < 16; ++r) Sacc[t][r] = 0.f;
  __syncthreads();
  for (int step = 0; step < nchunk; ++step) {
    const int cgk = chunk0 + (dir ? nchunk - 1 - step : step);
    const size_t blk = (size_t)((dir * 4 + head) * 256 + cgk);
    const bf16_t* gq_c = gq + blk * 8192; const bf16_t* gk_c = gk + blk * 8192; const bf16_t* gkt_c = gkt + blk * 8192;
    const bf16_t* vt_c = vgT + ((size_t)(head * 256 + cgk) * 256 + slice * 64) * 64;
    const float* e_c = ge + blk * 128;
    bf16x8 qf[8], kf[8], vf[4];
#pragma unroll
    for (int s = 0; s < 8; ++s) { qf[s] = *(const bf16x8*)(gq_c + (wi * 32 + l31) * 128 + s * 16 + h * 8); kf[s] = *(const bf16x8*)(gk_c + (wd * 32 + l31) * 128 + s * 16 + h * 8); }
#pragma unroll
    for (int s = 0; s < 4; ++s) vf[s] = *(const bf16x8*)(vt_c + (wd * 32 + l31) * 64 + s * 16 + h * 8);
    f32x16 X;
#pragma unroll
    for (int r = 0; r < 16; ++r) X[r] = 0.f;
#pragma unroll
    for (int s = 0; s < 8; ++s) X = MFMA32(kf[s], qf[s], X);
    {
      const int gi_ = wi * 32 + l31;
#pragma unroll
      for (int q4 = 0; q4 < 4; ++q4) {
        float v[4];
#pragma unroll
        for (int e = 0; e < 4; ++e) { const int gj = wd * 32 + 8 * q4 + 4 * h + e; const bool keep = dir ? (gj >= gi_) : (gj <= gi_); v[e] = keep ? X[4 * q4 + e] : 0.f; }
        u32x2 o; o.x = pk_bf16(v[0], v[1]); o.y = pk_bf16(v[2], v[3]);
        *(u32x2*)(Am + gi_ * 72 + wd * 32 + 8 * q4 + 4 * h) = o;
      }
    }
    f32x16 o;
#pragma unroll
    for (int r = 0; r < 16; ++r) o[r] = 0.f;
#pragma unroll
    for (int s = 0; s < 8; ++s) { const bf16x8 sf = *(const bf16x8*)(St + (wd * 32 + l31) * 136 + s * 16 + h * 8); o = MFMA32(qf[s], sf, o); }
    __syncthreads();
#pragma unroll
    for (int s = 0; s < 4; ++s) { const bf16x8 af = *(const bf16x8*)(Am + (wi * 32 + l31) * 72 + s * 16 + h * 8); o = MFMA32(af, vf[s], o); }
    {
      const size_t tokb = (size_t)cgk * 64 + wi * 32;
#pragma unroll
      for (int r = 0; r < 16; ++r) od[(tokb + crow(r, h)) * 1024 + head * 256 + slice * 64 + wd * 32 + l31] = f2bf(o[r]);
    }
#pragma unroll
    for (int t = 0; t < 2; ++t) {
      const int dkb = 2 * wi + t;
#pragma unroll
      for (int s = 0; s < 4; ++s) { const bf16x8 ktf = *(const bf16x8*)(gkt_c + (dkb * 32 + l31) * 64 + s * 16 + h * 8); Sacc[t] = MFMA32(ktf, vf[s], Sacc[t]); }
#pragma unroll
      for (int q4 = 0; q4 < 4; ++q4) { const f32x4 ev = *(const f32x4*)(e_c + dkb * 32 + 8 * q4 + 4 * h);
#pragma unroll
        for (int e = 0; e < 4; ++e) Sacc[t][4 * q4 + e] *= ev[e]; }
    }
    __syncthreads();
#pragma unroll
    for (int t = 0; t < 2; ++t) {
      const int dkb = 2 * wi + t;
#pragma unroll
      for (int q4 = 0; q4 < 4; ++q4) {
        u32x2 w; w.x = pk_bf16(Sacc[t][4 * q4], Sacc[t][4 * q4 + 1]); w.y = pk_bf16(Sacc[t][4 * q4 + 2], Sacc[t][4 * q4 + 3]);
        *(u32x2*)(St + (wd * 32 + l31) * 136 + dkb * 32 + 8 * q4 + 4 * h) = w;
      }
    }
    __syncthreads();
  }
}

DI int t5_bucket(int rel) {
  const int n = rel < 0 ? -rel : rel; int b;
  if (n < 8) b = n; else b = 8 + (n >= 12) + (n >= 16) + (n >= 23) + (n >= 32) + (n >= 46) + (n >= 64) + (n >= 91);
  if (b > 15) b = 15;
  return b + (rel > 0 ? 16 : 0);
}

DI void attn_item(const Params& p, int g, int item, char* smem, float lam) {
  const GroupInfo gi = group_info(p, g);
  const int S = gi.S, nq = S >> 7;
  const int seq = item / (8 * nq), rem = item - seq * 8 * nq, hd = rem / nq, qt = rem - hd * nq;
  const int sb = seq * S, q0 = qt * 128;
  bf16_t* Ks = (bf16_t*)smem;
  bf16_t* Vs = Ks + 2 * 32 * 72;
  float* tab = (float*)(Vs + 2 * 128 * 40);
  const bf16_t* proj = (const bf16_t*)(p.ws + OFF_PROJ); const bf16_t* vaT = (const bf16_t*)(p.ws + OFF_VAT); bf16_t* oa = (bf16_t*)(p.ws + OFF_OA);
  const int tid = threadIdx.x, lane = tid & 63, wave = tid >> 6, h_ = lane >> 5, l31_ = lane & 31;
  __syncthreads();
  for (int i = tid; i < 257; i += 256) tab[i] = p.rel_bias[t5_bucket(i - 128) * 8 + hd] * LOG2E;
  const bf16_t* qrow = proj + (size_t)(sb + q0 + wave * 32 + l31_) * NPROJ + hd * 128 + h_ * 8;
  const int kr0 = tid >> 3, kc = (tid & 7) * 8;
  const int vr0 = tid >> 2, vc = (tid & 3) * 8;
  const bf16_t* vsrc = vaT + (size_t)(hd * 128 + vr0) * TOKG + sb + vc;
  const int nsteps = S >> 5;
  const int qw0 = q0 + wave * 32;
#pragma unroll 1
  for (int m = 0; m < 2; ++m) {
    bf16x8 qf[4];
#pragma unroll
    for (int s = 0; s < 4; ++s) qf[s] = *(const bf16x8*)(qrow + m * 64 + s * 16);
    f32x16 O[4];
#pragma unroll
    for (int dt = 0; dt < 4; ++dt)
#pragma unroll
      for (int r = 0; r < 16; ++r) O[dt][r] = 0.f;
    float ls = 0.f;
    const bf16_t* ksrc = proj + (size_t)(sb + kr0) * NPROJ + 1024 + hd * 128 + m * 64 + kc;
    u32x4 rk, rv[2];
    rk = *(const u32x4*)(ksrc);
    rv[0] = *(const u32x4*)(vsrc); rv[1] = *(const u32x4*)(vsrc + (size_t)64 * TOKG);
    __syncthreads();
    *(u32x4*)(Ks + kr0 * 72 + kc) = rk;
    *(u32x4*)(Vs + vr0 * 40 + vc) = rv[0]; *(u32x4*)(Vs + (vr0 + 64) * 40 + vc) = rv[1];
    __syncthreads();
    for (int st = 0; st < nsteps; ++st) {
      const int buf = st & 1, k0 = st * 32, h = h_, l31 = l31_;
      if (st + 1 < nsteps) {
        rk = *(const u32x4*)(ksrc + (size_t)(k0 + 32) * NPROJ);
        const bf16_t* vs2 = vsrc + (k0 + 32);
        rv[0] = *(const u32x4*)(vs2); rv[1] = *(const u32x4*)(vs2 + (size_t)64 * TOKG);
      }
      const bf16_t* Kb = Ks + buf * 32 * 72; const bf16_t* Vb = Vs + buf * 128 * 40;
      const int rmin = k0 - (qw0 + 31), rmax = k0 + 31 - qw0;
      const int rel0 = k0 - (qw0 + l31) + 128;
      f32x16 X;
#pragma unroll
      for (int r = 0; r < 16; ++r) X[r] = 0.f;
#pragma unroll
      for (int s = 0; s < 4; ++s) { const bf16x8 kf = *(const bf16x8*)(Kb + l31 * 72 + s * 16 + h * 8); X = MFMA32(kf, qf[s], X); }
      if (rmin >= 128 || rmax <= -128) {
        const float bc = (rmin >= 128) ? tab[256] : tab[0];
#pragma unroll
        for (int r = 0; r < 16; ++r) X[r] = __builtin_amdgcn_exp2f(X[r] + bc);
      } else {
#pragma unroll
        for (int r = 0; r < 16; ++r) { int idx = rel0 + crow(r, h); idx = idx < 0 ? 0 : (idx > 256 ? 256 : idx); X[r] = __builtin_amdgcn_exp2f(X[r] + tab[idx]); }
      }
      float sum = 0.f;
#pragma unroll
      for (int r = 0; r < 16; ++r) sum += X[r];
      ls += sum;
      bf16x8 pf[2];
#pragma unroll
      for (int s2 = 0; s2 < 2; ++s2) {
        u32x4 w; w.x = pk_bf16(X[8 * s2], X[8 * s2 + 1]); w.y = pk_bf16(X[8 * s2 + 2], X[8 * s2 + 3]); w.z = pk_bf16(X[8 * s2 + 4], X[8 * s2 + 5]); w.w = pk_bf16(X[8 * s2 + 6], X[8 * s2 + 7]);
        pf[s2] = __builtin_bit_cast(bf16x8, w);
      }
#pragma unroll
      for (int s2 = 0; s2 < 2; ++s2)
#pragma unroll
        for (int dt = 0; dt < 4; ++dt) {
          const bf16x8 vf = *(const bf16x8*)(Vb + (dt * 32 + l31) * 40 + s2 * 16 + h * 8);
          O[dt] = MFMA32(pf[s2], vf, O[dt]);
        }
      if (st + 1 < nsteps) {
        bf16_t* Kn = Ks + (buf ^ 1) * 32 * 72; bf16_t* Vn = Vs + (buf ^ 1) * 128 * 40;
        *(u32x4*)(Kn + kr0 * 72 + kc) = rk;
        *(u32x4*)(Vn + vr0 * 40 + vc) = rv[0]; *(u32x4*)(Vn + (vr0 + 64) * 40 + vc) = rv[1];
      }
      __syncthreads();
    }
    ls += __shfl_xor(ls, 32);
    int h = h_, l31 = l31_; OPAQUE(h); OPAQUE(l31);
    bf16_t* obase = oa + (size_t)(sb + q0 + wave * 32) * 1024 + hd * 128 + l31;
    if (m == 0) {
      const float inv = 1.f / ls;
#pragma unroll
      for (int r = 0; r < 16; ++r) {
        const float a = __shfl(inv, crow(r, h));
#pragma unroll
        for (int dt = 0; dt < 4; ++dt) obase[crow(r, h) * 1024 + dt * 32] = f2bf(O[dt][r] * a);
        asm volatile("" ::: "memory");
      }
    } else {
      const float inv = lam / ls;
      float sg[4];
#pragma unroll
      for (int dt = 0; dt < 4; ++dt) sg[dt] = p.subln_g[dt * 32 + l31] * 0.8f;
#pragma unroll
      for (int r = 0; r < 16; ++r) {
        const float a = __shfl(inv, crow(r, h));
        float f[4]; float ss = 0.f;
#pragma unroll
        for (int dt = 0; dt < 4; ++dt) { f[dt] = bf2f(obase[crow(r, h) * 1024 + dt * 32]) - O[dt][r] * a; ss += f[dt] * f[dt]; }
        ss = half_sum32(ss);
        const float rs = rsqrtf(ss * (1.f / 128.f) + EPSN);
#pragma unroll
        for (int dt = 0; dt < 4; ++dt) obase[crow(r, h) * 1024 + dt * 32] = f2bf(f[dt] * rs * sg[dt]);
        asm volatile("" ::: "memory");
      }
    }
  }
}

DI void phase_mixers(const Params& p, int g, char* smem, int* s_item) {
  const GroupInfo gi = group_info(p, g);
  int* ctr = (int*)(p.ws + OFF_MISC) + g;
  const float lam = *(const float*)(p.ws + OFF_MISC + 64);
  const int nscan = gi.nseq * 32, total = nscan + 1024;
  for (;;) {
    __syncthreads();
    if (threadIdx.x == 0) *s_item = atomicAdd(ctr, 1);
    __syncthreads();
    const int item = *s_item;
    if (item >= total) break;
#if defined(MIX_ONLY) && MIX_ONLY == 1
    gla_scan_unit(p, g, item, smem);
#elif defined(MIX_ONLY) && MIX_ONLY == 2
    attn_item(p, g, item, smem, lam);
#else
    if (item < nscan) gla_scan_unit(p, g, item, smem); else attn_item(p, g, item - nscan, smem, lam);
#endif
  }
}

DI void phase_gla_norm(const Params& p, int g, int bid, int nb) {
  const GroupInfo gi = group_info(p, g);
  const bf16_t* of = (const bf16_t*)gi.out; const bf16_t* ob = of + (size_t)TOKG * 1024;
  const bf16_t* proj = (const bf16_t*)(p.ws + OFF_PROJ); bf16_t* dst = (bf16_t*)(p.ws + OFF_H);
  const int lane = threadIdx.x & 63, wave = threadIdx.x >> 6;
  const f32x4 gn = *(const f32x4*)(p.gla_norm_g + lane * 4);
  for (int it = bid * 4 + wave; it < TOKG * 4; it += nb * 4) {
    const int tok = it >> 2, head = it & 3;
    const size_t base = (size_t)tok * 1024 + head * 256 + lane * 4;
    const u32x2 a = *(const u32x2*)(of + base), b = *(const u32x2*)(ob + base), c = *(const u32x2*)(proj + (size_t)tok * NPROJ + 3072 + head * 256 + lane * 4);
    float v[4], og[4];
    v[0] = __uint_as_float(a.x << 16) + __uint_as_float(b.x << 16); v[1] = __uint_as_float(a.x & 0xffff0000u) + __uint_as_float(b.x & 0xffff0000u);
    v[2] = __uint_as_float(a.y << 16) + __uint_as_float(b.y << 16); v[3] = __uint_as_float(a.y & 0xffff0000u) + __uint_as_float(b.y & 0xffff0000u);
    og[0] = __uint_as_float(c.x << 16); og[1] = __uint_as_float(c.x & 0xffff0000u); og[2] = __uint_as_float(c.y << 16); og[3] = __uint_as_float(c.y & 0xffff0000u);
    float ss = v[0] * v[0] + v[1] * v[1] + v[2] * v[2] + v[3] * v[3];
#pragma unroll
    for (int m = 32; m >= 1; m >>= 1) ss += __shfl_xor(ss, m);
    const float rs = rsqrtf(ss * (1.f / 256.f) + EPSN);
    u32x2 o; o.x = pk_bf16(v[0] * rs * gn[0] * og[0], v[1] * rs * gn[1] * og[1]); o.y = pk_bf16(v[2] * rs * gn[2] * og[2], v[3] * rs * gn[3] * og[3]);
    *(u32x2*)(dst + base) = o;
  }
}

DI void phase_merge(const Params& p, int g, char* smem, int bid, int nb) {
  bf16_t* As = (bf16_t*)smem; bf16_t* Bs = As + 128 * 72;
  const bf16_t* OA = (const bf16_t*)(p.ws + OFF_OA); const bf16_t* OB = (const bf16_t*)(p.ws + OFF_H);
  const bf16_t* WA = (const bf16_t*)(p.ws + OFF_WA); const bf16_t* WB = (const bf16_t*)(p.ws + OFF_WB);
  const bf16_t* proj = (const bf16_t*)(p.ws + OFF_PROJ); bf16_t* mg = (bf16_t*)(p.ws + OFF_GQ);
  const int lane = threadIdx.x & 63, wave = threadIdx.x >> 6, wm_ = wave >> 1, wn_ = wave & 1, h_ = lane >> 5, l31_ = lane & 31;
  TileSched ts(bid, nb, 8);
  int mt, nt;
  while (ts.next(mt, nt)) {
    f32x16 acc[2][2]; zero_acc(acc);
    gemm_tile<false>(OA + (size_t)mt * 128 * 1024, 1024, WA + (size_t)nt * 128 * 1024, 1024, 1024, acc, As, Bs);
    int wm = wm_, wn = wn_, h = h_, l31 = l31_; OPAQUE(wm); OPAQUE(wn); OPAQUE(h); OPAQUE(l31);
    const bf16_t* pt = proj + (size_t)mt * 128 * NPROJ; bf16_t* mgt = mg + (size_t)mt * 128 * 1024;
#pragma unroll
    for (int mi = 0; mi < 2; ++mi)
#pragma unroll
      for (int ni = 0; ni < 2; ++ni)
#pragma unroll
        for (int r = 0; r < 16; ++r) {
          const int off = (wm * 64 + mi * 32 + crow(r, h)) * NPROJ + nt * 128 + wn * 64 + ni * 32 + l31;
          const float sga = bf2f(pt[off + 4096]), sgb = fmaxf(bf2f(pt[off + 5120]), 1e-20f);
          acc[mi][ni][r] *= sga / sgb;
          if ((r & 3) == 3) asm volatile("" ::: "memory");
        }
    gemm_tile<false>(OB + (size_t)mt * 128 * 1024, 1024, WB + (size_t)nt * 128 * 1024, 1024, 1024, acc, As, Bs);
    OPAQUE(wm); OPAQUE(wn); OPAQUE(h); OPAQUE(l31);
#pragma unroll
    for (int mi = 0; mi < 2; ++mi)
#pragma unroll
      for (int ni = 0; ni < 2; ++ni)
#pragma unroll
        for (int r = 0; r < 16; ++r) {
          const int rl = wm * 64 + mi * 32 + crow(r, h), cl = nt * 128 + wn * 64 + ni * 32 + l31;
          mgt[rl * 1024 + cl] = f2bf(acc[mi][ni][r] * fmaxf(bf2f(pt[rl * NPROJ + cl + 5120]), 1e-20f));
          if ((r & 3) == 3) asm volatile("" ::: "memory");
        }
  }
}

DI void phase_outproj(const Params& p, int g, char* smem, int bid, int nb) {
  const GroupInfo gi = group_info(p, g);
  bf16_t* As = (bf16_t*)smem; bf16_t* Bs = As + 128 * 72;
  const bf16_t* MG = (const bf16_t*)(p.ws + OFF_GQ); const bf16_t* WO = (const bf16_t*)(p.ws + OFF_WO);
  const float* mod = (const float*)(p.ws + OFF_MOD);
  const int lane = threadIdx.x & 63, wave = threadIdx.x >> 6, wm_ = wave >> 1, wn_ = wave & 1, h_ = lane >> 5, l31_ = lane & 31;
  TileSched ts(bid, nb, 8);
  int mt, nt;
  while (ts.next(mt, nt)) {
    f32x16 acc[2][2]; zero_acc(acc);
    gemm_tile<false>(MG + (size_t)mt * 128 * 1024, 1024, WO + (size_t)nt * 128 * 1024, 1024, 1024, acc, As, Bs);
    int wm = wm_, wn = wn_, h = h_, l31 = l31_; OPAQUE(wm); OPAQUE(wn); OPAQUE(h); OPAQUE(l31);
    const int b = row_batch(gi, mt * 128);
    const float* xt = gi.x + (size_t)mt * 128 * 1024; float* ot = gi.out + (size_t)mt * 128 * 1024;
#pragma unroll
    for (int ni = 0; ni < 2; ++ni) {
      const int col = nt * 128 + wn * 64 + ni * 32 + l31;
      const float gt = mod[b * 6144 + 2048 + col];
#pragma unroll
      for (int mi = 0; mi < 2; ++mi) {
#pragma unroll
        for (int r = 0; r < 16; ++r) {
          const int off = (wm * 64 + mi * 32 + crow(r, h)) * 1024 + col;
          ot[off] = xt[off] + gt * acc[mi][ni][r];
        }
        asm volatile("" ::: "memory");
      }
    }
  }
}

DI void phase_up(const Params& p, int g, char* smem, int bid, int nb) {
  bf16_t* As = (bf16_t*)smem; bf16_t* Bs = As + 128 * 72;
  const bf16_t* H2 = (const bf16_t*)(p.ws + OFF_H); const bf16_t* WU = (const bf16_t*)(p.ws + OFF_WUP); bf16_t* U = (bf16_t*)(p.ws + OFF_PROJ);
  const int lane = threadIdx.x & 63, wave = threadIdx.x >> 6, wm_ = wave >> 1, wn_ = wave & 1, h_ = lane >> 5, l31_ = lane & 31;
  TileSched ts(bid, nb, 32);
  int mt, nt;
  while (ts.next(mt, nt)) {
    f32x16 acc[2][2]; zero_acc(acc);
    gemm_tile<false>(H2 + (size_t)mt * 128 * 1024, 1024, WU + (size_t)nt * 128 * 1024, 1024, 1024, acc, As, Bs);
    int wm = wm_, wn = wn_, h = h_, l31 = l31_; OPAQUE(wm); OPAQUE(wn); OPAQUE(h); OPAQUE(l31);
#pragma unroll
    for (int mi = 0; mi < 2; ++mi)
#pragma unroll
      for (int ni = 0; ni < 2; ++ni)
#pragma unroll
        for (int r = 0; r < 16; ++r) {
          const float v = fmaxf(acc[mi][ni][r], 0.f);
          (U + (size_t)mt * 128 * 4096)[(wm * 64 + mi * 32 + crow(r, h)) * 4096 + nt * 128 + wn * 64 + ni * 32 + l31] = f2bf(v * v);
        }
  }
}

DI void phase_down(const Params& p, int g, char* smem, int bid, int nb) {
  const GroupInfo gi = group_info(p, g);
  bf16_t* As = (bf16_t*)smem; bf16_t* Bs = As + 128 * 72;
  const bf16_t* U = (const bf16_t*)(p.ws + OFF_PROJ); const bf16_t* WD = (const bf16_t*)(p.ws + OFF_WDN);
  const float* mod = (const float*)(p.ws + OFF_MOD);
  const int lane = threadIdx.x & 63, wave = threadIdx.x >> 6, wm_ = wave >> 1, wn_ = wave & 1, h_ = lane >> 5, l31_ = lane & 31;
  TileSched ts(bid, nb, 8);
  int mt, nt;
  while (ts.next(mt, nt)) {
    f32x16 acc[2][2]; zero_acc(acc);
    gemm_tile<false>(U + (size_t)mt * 128 * 4096, 4096, WD + (size_t)nt * 128 * 4096, 4096, 4096, acc, As, Bs);
    int wm = wm_, wn = wn_, h = h_, l31 = l31_; OPAQUE(wm); OPAQUE(wn); OPAQUE(h); OPAQUE(l31);
    const int b = row_batch(gi, mt * 128);
    float* ot = gi.out + (size_t)mt * 128 * 1024;
#pragma unroll
    for (int ni = 0; ni < 2; ++ni) {
      const int col = nt * 128 + wn * 64 + ni * 32 + l31;
      const float gt = mod[b * 6144 + 5120 + col];
#pragma unroll
      for (int mi = 0; mi < 2; ++mi) {
#pragma unroll
        for (int r = 0; r < 16; ++r) {
          const int off = (wm * 64 + mi * 32 + crow(r, h)) * 1024 + col;
          ot[off] += gt * acc[mi][ni][r];
        }
        asm volatile("" ::: "memory");
      }
    }
  }
}

constexpr int SMEM_BYTES = 17 * 512 * 4 + 4 * 17 * 64 * 4;

DI void run_phase(const Params& p, int ph, int g, char* smem, int* s_item, int bid, int nb) {
  switch (ph) {
    case 0: phase_prologue(p, smem, bid, nb); break;
    case 1: { const GroupInfo gi = group_info(p, g); phase_modnorm(p, g, gi.x, p.norm1_g, 0, 1024, bid, nb); } break;
    case 2: phase_gemm1(p, g, smem, bid, nb); break;
    case 3: phase_gla_prep(p, g, smem, bid, nb); break;
    case 4: phase_mixers(p, g, smem, s_item); break;
    case 5: phase_gla_norm(p, g, bid, nb); break;
    case 6: phase_merge(p, g, smem, bid, nb); break;
    case 7: phase_outproj(p, g, smem, bid, nb); break;
    case 8: { const GroupInfo gi = group_info(p, g); phase_modnorm(p, g, gi.out, p.norm2_g, 3072, 4096, bid, nb); } break;
    case 9: phase_up(p, g, smem, bid, nb); break;
    case 10: phase_down(p, g, smem, bid, nb); break;
    default: break;
  }
}

template <int PH>
__global__ void __launch_bounds__(256, 2) k_phase(Params p, int g) {
  __shared__ __attribute__((aligned(16))) char smem[SMEM_BYTES];
  __shared__ int s_item;
  run_phase(p, PH, g, smem, &s_item, blockIdx.x, gridDim.x);
}
template <int PH> static void launch_phase(const Params& p, int g, hipStream_t stream) { k_phase<PH><<<512, 256, 0, stream>>>(p, g); }

#if ONE_LAUNCH
__global__ void __launch_bounds__(256, 2) k_mega(Params p) {
  __shared__ __attribute__((aligned(16))) char smem[SMEM_BYTES];
  __shared__ int s_item;
  cg::grid_group grid = cg::this_grid();
  const int bid = blockIdx.x, nb = gridDim.x;
  run_phase(p, 0, 0, smem, &s_item, bid, nb);
  grid.sync();
  for (int g = 0; g < 3; ++g) {
    for (int ph = 1; ph <= 10; ++ph) {
      run_phase(p, ph, g, smem, &s_item, bid, nb);
      grid.sync();
    }
  }
}
#endif

extern "C" void kernel_launch(void* const* d_in, const int* in_sizes, int n_in, void* d_out, int out_size, void* d_ws, size_t ws_size, hipStream_t stream) {
  Params p{};
  const float** pp = (const float**)&p;
  for (int i = 0; i < 27; ++i) pp[i] = (const float*)d_in[i];
  p.out = (float*)d_out;
  p.ws = (char*)d_ws;
  if (ws_size < WS_TOTAL) { fprintf(stderr, "workspace too small: %zu < %zu\n", ws_size, (size_t)WS_TOTAL); return; }
#if ONE_LAUNCH
  static int grid_blocks = 0;
  if (!grid_blocks) {
    int dev = 0, cus = 0, per_cu = 0;
    hipGetDevice(&dev);
    hipDeviceGetAttribute(&cus, hipDeviceAttributeMultiprocessorCount, dev);
    hipOccupancyMaxActiveBlocksPerMultiprocessor(&per_cu, k_mega, 256, 0);
    if (per_cu > 2) per_cu = 2;
    grid_blocks = cus * per_cu;
  }
  void* args[] = {&p};
  hipError_t e = hipLaunchCooperativeKernel((void*)k_mega, dim3(grid_blocks), dim3(256), args, 0, stream);
  if (e != hipSuccess) fprintf(stderr, "cooperative launch failed: %s (grid %d)\n", hipGetErrorString(e), grid_blocks);
#else
  launch_phase<0>(p, 0, stream);
  for (int g = 0; g < 3; ++g) {
    launch_phase<1>(p, g, stream); launch_phase<2>(p, g, stream); launch_phase<3>(p, g, stream); launch_phase<4>(p, g, stream); launch_phase<5>(p, g, stream);
    launch_phase<6>(p, g, stream); launch_phase<7>(p, g, stream); launch_phase<8>(p, g, stream); launch_phase<9>(p, g, stream); launch_phase<10>(p, g, stream);
  }
#endif
}
```

```cpp
#include <hip/hip_runtime.h>
#include <hip/hip_cooperative_groups.h>
#include <cstdint>
#include <cstdio>
namespace cg = cooperative_groups;

#ifndef ONE_LAUNCH
#define ONE_LAUNCH 1
#endif

#define DI __device__ __forceinline__
typedef unsigned short bf16_t;
typedef short bf16x8 __attribute__((ext_vector_type(8)));
typedef float f32x16 __attribute__((ext_vector_type(16)));
typedef float f32x4 __attribute__((ext_vector_type(4)));
typedef float f32x2 __attribute__((ext_vector_type(2)));
typedef unsigned u32x4 __attribute__((ext_vector_type(4)));
typedef unsigned u32x2 __attribute__((ext_vector_type(2)));
typedef __bf16 bf16v2 __attribute__((ext_vector_type(2)));
#define OPAQUE(x) asm volatile("" : "+v"(x))
__shared__ int g_wave_tab[64];
__device__ __forceinline__ unsigned hw_slot() { return (unsigned)__builtin_amdgcn_s_getreg((5 << 11) | 4) & 63u; }
__device__ __forceinline__ void TID_init() { if ((threadIdx.x & 63) == 0) g_wave_tab[hw_slot()] = (int)(threadIdx.x >> 6); __syncthreads(); }
__device__ __forceinline__ int TID() {
  int lane = (int)__builtin_amdgcn_mbcnt_hi(~0u, __builtin_amdgcn_mbcnt_lo(~0u, 0u));
  int t = g_wave_tab[hw_slot()] * 64 + lane; asm volatile("" : "+v"(t)); return t;
}
#define MFMA32(a, b, c) __builtin_amdgcn_mfma_f32_32x32x16_bf16((a), (b), (c), 0, 0, 0)

constexpr int TOKG = 16384;
constexpr int NPROJ = 6144;
constexpr float EPSN = 1e-6f;
constexpr float LOG2E = 1.4426950408889634f;
constexpr float QSCALE = 0.125f * LOG2E;

constexpr size_t MiB = 1024 * 1024;
constexpr size_t OFF_WIN = 0;
constexpr size_t OFF_WA = OFF_WIN + (size_t)8320 * 1024 * 2;
constexpr size_t OFF_WB = OFF_WA + 2 * MiB;
constexpr size_t OFF_WO = OFF_WB + 2 * MiB;
constexpr size_t OFF_WUP = OFF_WO + 2 * MiB;
constexpr size_t OFF_WDN = OFF_WUP + 8 * MiB;
constexpr size_t OFF_MOD = OFF_WDN + 8 * MiB;
constexpr size_t OFF_MISC = OFF_MOD + 512 * 1024;
constexpr size_t OFF_BAR = OFF_MISC + 4096;
constexpr size_t OFF_H = OFF_MISC + 32768;
constexpr size_t OFF_PROJ = OFF_H + 32 * MiB;
constexpr size_t OFF_VAT = OFF_PROJ + 192 * MiB;
constexpr size_t OFF_VGT = OFF_VAT + 32 * MiB;
constexpr size_t OFF_LR = OFF_VGT + 32 * MiB;
constexpr size_t OFF_GQ = OFF_LR + 2 * MiB;
constexpr size_t OFF_GK = OFF_GQ + 32 * MiB;
constexpr size_t OFF_GKT = OFF_GK + 32 * MiB;
constexpr size_t OFF_GE = OFF_GKT + 32 * MiB;
constexpr size_t OFF_OA = OFF_GE + 1 * MiB;
constexpr size_t OFF_OA2 = OFF_OA + 32 * MiB;
constexpr size_t WS_TOTAL = OFF_OA2 + 32 * MiB;

struct Params {
  const float *x_prompt, *x_sample, *c_prompt, *c_sample, *rel_bias, *w_ada, *b_ada, *norm1_g, *w_in, *q_norm_g, *k_norm_g,
      *lam_q1, *lam_k1, *lam_q2, *lam_k2, *subln_g, *w_gate_f, *b_gate_f, *w_gate_b, *b_gate_b, *gla_norm_g, *w_branch_a,
      *w_branch_b, *w_out, *norm2_g, *w_up, *w_down;
  float* out;
  char* ws;
};

DI float bf2f(bf16_t v) { return __uint_as_float(((unsigned)v) << 16); }
DI unsigned pk_bf16(float lo, float hi) { f32x2 v = {lo, hi}; bf16v2 b = __builtin_convertvector(v, bf16v2); return __builtin_bit_cast(unsigned, b); }
DI bf16_t f2bf(float x) { return (bf16_t)(pk_bf16(x, 0.f) & 0xffffu); }
DI int crow(int r, int h) { return (r & 3) + 8 * (r >> 2) + 4 * h; }
DI float sigmoidf_(float x) { return 1.f / (1.f + __expf(-x)); }
DI int permpos(int t) { return (t & ~12) | ((t & 4) << 1) | ((t & 8) >> 1); }
template <int M> DI float xor_swz(float v) { return __int_as_float(__builtin_amdgcn_ds_swizzle(__float_as_int(v), 0x1F | (M << 10))); }
DI float half_sum32(float v) {
  v += xor_swz<1>(v); v += xor_swz<2>(v); v += xor_swz<4>(v); v += xor_swz<8>(v); v += xor_swz<16>(v); return v;
}
DI float half_swap_sum(float v) { auto r = __builtin_amdgcn_permlane32_swap(__float_as_uint(v), __float_as_uint(v), false, false); return __uint_as_float(r[0]) + __uint_as_float(r[1]); }
DI float wave_sum64(float v) { return half_swap_sum(half_sum32(v)); }
DI void zero_acc(f32x16 (&acc)[2][2]) {
#pragma unroll
  for (int a = 0; a < 2; ++a)
#pragma unroll
    for (int b = 0; b < 2; ++b)
#pragma unroll
      for (int r = 0; r < 16; ++r) acc[a][b][r] = 0.f;
}

struct GroupInfo { int S, nseq, b0; const float* x; float* out; };
DI GroupInfo group_info(const Params& p, int g) {
  GroupInfo gi;
  if (g == 0) { gi.S = 16384; gi.nseq = 1; gi.b0 = 0; gi.x = p.x_prompt; }
  else { gi.S = 2048; gi.nseq = 8; gi.b0 = 1 + (g - 1) * 8; gi.x = p.x_sample + (size_t)(g - 1) * TOKG * 1024; }
  gi.out = p.out + (size_t)g * TOKG * 1024;
  return gi;
}
DI int row_batch(const GroupInfo& gi, int row) { return gi.b0 + (gi.nseq == 1 ? 0 : (row >> 11)); }

template <bool SWAP>
DI void gemm_tile(const bf16_t* __restrict__ A, int lda, const bf16_t* __restrict__ Bt, int ldb, int K, f32x16 (&acc)[2][2], bf16_t* As, bf16_t* Bs) {
  const int tid = TID(), lane = tid & 63, wave = tid >> 6, wm = wave >> 1, wn = wave & 1;
  const int lr = tid >> 3, lc = (tid & 7) * 8;
  const bf16_t* ga = A + (size_t)lr * lda + lc;
  const bf16_t* gb = Bt + (size_t)lr * ldb + lc;
  u32x4 ra0[4], rb0[4], ra1[4], rb1[4];
#pragma unroll
  for (int i = 0; i < 4; ++i) { ra0[i] = *(const u32x4*)(ga + (size_t)(32 * i) * lda); rb0[i] = *(const u32x4*)(gb + (size_t)(32 * i) * ldb); }
#pragma unroll
  for (int i = 0; i < 4; ++i) { ra1[i] = *(const u32x4*)(ga + (size_t)(32 * i) * lda + 64); rb1[i] = *(const u32x4*)(gb + (size_t)(32 * i) * ldb + 64); }
  const int fr = lane & 31, fk = (lane >> 5) * 8;
  const bf16_t* pa = As + (wm * 64 + fr) * 72 + fk;
  const bf16_t* pb = Bs + (wn * 64 + fr) * 72 + fk;
  auto compute = [&]() __attribute__((always_inline)) {
#pragma unroll
    for (int s = 0; s < 4; ++s) {
      const bf16x8 a0 = *(const bf16x8*)(pa + s * 16), a1 = *(const bf16x8*)(pa + 32 * 72 + s * 16);
      const bf16x8 b0 = *(const bf16x8*)(pb + s * 16), b1 = *(const bf16x8*)(pb + 32 * 72 + s * 16);
      if (SWAP) {
        acc[0][0] = MFMA32(b0, a0, acc[0][0]); acc[0][1] = MFMA32(b1, a0, acc[0][1]);
        acc[1][0] = MFMA32(b0, a1, acc[1][0]); acc[1][1] = MFMA32(b1, a1, acc[1][1]);
      } else {
        acc[0][0] = MFMA32(a0, b0, acc[0][0]); acc[0][1] = MFMA32(a0, b1, acc[0][1]);
        acc[1][0] = MFMA32(a1, b0, acc[1][0]); acc[1][1] = MFMA32(a1, b1, acc[1][1]);
      }
    }
  };
  for (int k0 = 0; k0 < K; k0 += 128) {
    __syncthreads();
#pragma unroll
    for (int i = 0; i < 4; ++i) { *(u32x4*)(As + (lr + 32 * i) * 72 + lc) = ra0[i]; *(u32x4*)(Bs + (lr + 32 * i) * 72 + lc) = rb0[i]; }
    __syncthreads();
    if (k0 + 128 < K) {
#pragma unroll
      for (int i = 0; i < 4; ++i) { ra0[i] = *(const u32x4*)(ga + (size_t)(32 * i) * lda + k0 + 128); rb0[i] = *(const u32x4*)(gb + (size_t)(32 * i) * ldb + k0 + 128); }
    }
    compute();
    __syncthreads();
#pragma unroll
    for (int i = 0; i < 4; ++i) { *(u32x4*)(As + (lr + 32 * i) * 72 + lc) = ra1[i]; *(u32x4*)(Bs + (lr + 32 * i) * 72 + lc) = rb1[i]; }
    __syncthreads();
    if (k0 + 192 < K) {
#pragma unroll
      for (int i = 0; i < 4; ++i) { ra1[i] = *(const u32x4*)(ga + (size_t)(32 * i) * lda + k0 + 192); rb1[i] = *(const u32x4*)(gb + (size_t)(32 * i) * ldb + k0 + 192); }
    }
    compute();
  }
}

struct TileSched {
  int j, step, total, NT, xcd, simple;
  DI TileSched(int bid, int nb, int NT_) {
    NT = NT_;
    if ((nb & 7) == 0) { xcd = bid & 7; j = bid >> 3; step = nb >> 3; total = 16 * NT; simple = 0; }
    else { xcd = 0; j = bid; step = nb; total = 128 * NT; simple = 1; }
  }
  DI bool next(int& mt, int& nt) {
    if (j >= total) return false;
    if (simple) { mt = j & 127; nt = j >> 7; }
    else { const int half = j / (8 * NT), jj = j - half * 8 * NT; mt = xcd * 16 + half * 8 + (jj & 7); nt = jj >> 3; }
    j += step; return true;
  }
};

DI int win_src_col(int n) { return n < 6144 ? n : (n < 8192 ? n + 32 : (n < 8224 ? n - 2048 : -1)); }

DI void transpose_tile(const float* __restrict__ W, int ldw, bf16_t* __restrict__ Wt, int K, int kt, int nt, bool is_win, float* sm) {
  const int tid = TID(), c = tid & 63, r0 = tid >> 6;
  const int n = nt * 64 + c; const int src = is_win ? win_src_col(n) : n;
  __syncthreads();
#pragma unroll
  for (int i = 0; i < 16; ++i) { const int k = r0 + 4 * i; sm[k * 65 + c] = (src >= 0) ? W[(size_t)(kt * 64 + k) * ldw + src] : 0.f; }
  __syncthreads();
#pragma unroll
  for (int i = 0; i < 16; ++i) { const int nn = r0 + 4 * i; Wt[(size_t)(nt * 64 + nn) * K + kt * 64 + c] = f2bf(sm[c * 65 + nn]); }
}

DI void mod_item(const Params& p, int cgi, char* smem) {
  float* tab = (float*)smem;
  float* red = tab + 17 * 512;
  float* mod = (float*)(p.ws + OFF_MOD);
  const int tid = TID(), cl = tid & 63, kq = tid >> 6, col = cgi * 64 + cl;
  float acc[17];
#pragma unroll
  for (int b = 0; b < 17; ++b) acc[b] = 0.f;
  for (int pass = 0; pass < 2; ++pass) {
    __syncthreads();
    for (int i = tid; i < 17 * 512; i += 256) {
      const int b = i >> 9, k = pass * 512 + (i & 511);
      const float cv = (b == 0) ? p.c_prompt[k] : p.c_sample[(b - 1) * 1024 + k];
      tab[i] = cv / (1.f + __expf(-cv));
    }
    __syncthreads();
    for (int kk = 0; kk < 128; kk += 16) {
      float w[16];
#pragma unroll
      for (int u = 0; u < 16; ++u) w[u] = p.w_ada[(size_t)(pass * 512 + kq * 128 + kk + u) * 6144 + col];
#pragma unroll
      for (int u = 0; u < 16; ++u) {
        const int k = kq * 128 + kk + u;
#pragma unroll
        for (int b = 0; b < 17; ++b) acc[b] += tab[b * 512 + k] * w[u];
      }
    }
  }
  __syncthreads();
#pragma unroll
  for (int b = 0; b < 17; ++b) red[(kq * 17 + b) * 64 + cl] = acc[b];
  __syncthreads();
  for (int i = tid; i < 17 * 64; i += 256) {
    const int b = i >> 6, c = i & 63;
    const float s = red[(0 * 17 + b) * 64 + c] + red[(1 * 17 + b) * 64 + c] + red[(2 * 17 + b) * 64 + c] + red[(3 * 17 + b) * 64 + c];
    mod[b * 6144 + cgi * 64 + c] = s + p.b_ada[cgi * 64 + c];
  }
}

DI void phase_prologue(const Params& p, char* smem, int bid, int nb) {
  constexpr int N0 = 96, N1 = N0 + 2080, N2 = N1 + 256, N3 = N2 + 256, N4 = N3 + 256, N5 = N4 + 1024, N6 = N5 + 1024;
  for (int it = bid; it < N6 + 1; it += nb) {
    if (it < N0) mod_item(p, it, smem);
    else if (it < N1) { const int t = it - N0; transpose_tile(p.w_in, 8224, (bf16_t*)(p.ws + OFF_WIN), 1024, t & 15, t >> 4, true, (float*)smem); }
    else if (it < N2) { const int t = it - N1; transpose_tile(p.w_branch_a, 1024, (bf16_t*)(p.ws + OFF_WA), 1024, t & 15, t >> 4, false, (float*)smem); }
    else if (it < N3) { const int t = it - N2; transpose_tile(p.w_branch_b, 1024, (bf16_t*)(p.ws + OFF_WB), 1024, t & 15, t >> 4, false, (float*)smem); }
    else if (it < N4) { const int t = it - N3; transpose_tile(p.w_out, 1024, (bf16_t*)(p.ws + OFF_WO), 1024, t & 15, t >> 4, false, (float*)smem); }
    else if (it < N5) { const int t = it - N4; transpose_tile(p.w_up, 4096, (bf16_t*)(p.ws + OFF_WUP), 1024, t & 15, t >> 4, false, (float*)smem); }
    else if (it < N6) { const int t = it - N5; transpose_tile(p.w_down, 1024, (bf16_t*)(p.ws + OFF_WDN), 4096, t & 63, t >> 6, false, (float*)smem); }
    else {
      int* ctr = (int*)(p.ws + OFF_MISC);
      if (TID() < 64) ctr[TID()] = 0;
      if (TID() >= 64 && TID() < 128) {
        const int l = TID() - 64;
        float a = p.lam_q1[l] * p.lam_k1[l], b = p.lam_q2[l] * p.lam_k2[l];
        a = wave_sum64(a); b = wave_sum64(b);
        if (l == 0) *(float*)(p.ws + OFF_MISC + 1024) = __expf(a) - __expf(b) + 0.2f;
      }
    }
  }
}

DI void phase_modnorm(const Params& p, int g, const float* xin, const float* gvec, int shift_off, int scale_off, int bid, int nb) {
  const GroupInfo gi = group_info(p, g);
  const float* mod = (const float*)(p.ws + OFF_MOD);
  bf16_t* hout = (bf16_t*)(p.ws + OFF_H);
  const int lane = TID() & 63, wave = TID() >> 6;
  for (int row = bid * 4 + wave; row < TOKG; row += nb * 4) {
    const int b = row_batch(gi, row);
    const float* xr = xin + (size_t)row * 1024;
    f32x4 v[4]; float ss = 0.f;
#pragma unroll
    for (int i = 0; i < 4; ++i) { v[i] = *(const f32x4*)(xr + i * 256 + lane * 4); ss += v[i][0] * v[i][0] + v[i][1] * v[i][1] + v[i][2] * v[i][2] + v[i][3] * v[i][3]; }
    ss = wave_sum64(ss);
    const float rs = rsqrtf(ss * (1.f / 1024.f) + EPSN);
#pragma unroll
    for (int i = 0; i < 4; ++i) {
      const int c = i * 256 + lane * 4;
      const f32x4 gv = *(const f32x4*)(gvec + c), sc = *(const f32x4*)(mod + b * 6144 + scale_off + c), sh = *(const f32x4*)(mod + b * 6144 + shift_off + c);
      f32x4 y;
#pragma unroll
      for (int e = 0; e < 4; ++e) y[e] = v[i][e] * rs * gv[e] * (1.f + sc[e]) + sh[e];
      u32x2 o; o.x = pk_bf16(y[0], y[1]); o.y = pk_bf16(y[2], y[3]);
      *(u32x2*)(hout + (size_t)row * 1024 + c) = o;
    }
  }
}

DI void phase_gemm1(const Params& p, int g, char* smem, int bid, int nb) {
  bf16_t* As = (bf16_t*)smem; bf16_t* Bs = As + 128 * 72;
  const bf16_t* H = (const bf16_t*)(p.ws + OFF_H); const bf16_t* W = (const bf16_t*)(p.ws + OFF_WIN);
  bf16_t* proj = (bf16_t*)(p.ws + OFF_PROJ); bf16_t* vaT = (bf16_t*)(p.ws + OFF_VAT); bf16_t* vgT = (bf16_t*)(p.ws + OFF_VGT);
  float* lrb = (float*)(p.ws + OFF_LR);
  TileSched ts(bid, nb, 65);
  int mt, nt;
  while (ts.next(mt, nt)) {
    f32x16 acc[2][2]; zero_acc(acc);
    const bool swp = (nt >= 16 && nt < 24) || (nt >= 32 && nt < 40);
    const bf16_t* A = H + (size_t)mt * 128 * 1024; const bf16_t* B = W + (size_t)nt * 128 * 1024;
    if (swp) gemm_tile<true>(A, 1024, B, 1024, 1024, acc, As, Bs); else gemm_tile<false>(A, 1024, B, 1024, 1024, acc, As, Bs);
    const int t_ = TID(); int wm = t_ >> 7, wn = (t_ >> 6) & 1, h = (t_ >> 5) & 1, l31 = t_ & 31;
    const int row0 = mt * 128;
    bf16_t* projt = proj + (size_t)row0 * NPROJ;
    if (nt < 16) {
      const float* gn = (nt < 8) ? p.q_norm_g : p.k_norm_g; const float sc = (nt < 8) ? QSCALE : 1.f;
      const float g0 = gn[l31] * sc, g1 = gn[32 + l31] * sc;
#pragma unroll
      for (int mi = 0; mi < 2; ++mi)
#pragma unroll
        for (int r = 0; r < 16; ++r) {
          const float a0 = acc[mi][0][r], a1 = acc[mi][1][r];
          const float ss = half_sum32(a0 * a0 + a1 * a1);
          const float rs = rsqrtf(ss * (1.f / 64.f) + EPSN);
          bf16_t* dst = projt + (wm * 64 + mi * 32 + crow(r, h)) * NPROJ + nt * 128 + wn * 64 + l31;
          dst[0] = f2bf(a0 * rs * g0); dst[32] = f2bf(a1 * rs * g1);
        }
    } else if (nt < 24) {
#pragma unroll
      for (int mi = 0; mi < 2; ++mi) {
        const int pp = permpos(row0 + wm * 64 + mi * 32 + l31);
#pragma unroll
        for (int ni = 0; ni < 2; ++ni)
#pragma unroll
          for (int r = 0; r < 16; ++r) { const int n = (nt - 16) * 128 + wn * 64 + ni * 32 + crow(r, h); vaT[(size_t)n * TOKG + pp] = f2bf(acc[mi][ni][r]); }
      }
    } else if (nt < 40 && nt >= 32) {
#pragma unroll
      for (int mi = 0; mi < 2; ++mi) {
        const int tok = row0 + wm * 64 + mi * 32 + l31, chunk = tok >> 6, tk = tok & 63;
#pragma unroll
        for (int ni = 0; ni < 2; ++ni)
#pragma unroll
          for (int r = 0; r < 16; ++r) {
            const int n = (nt - 32) * 128 + wn * 64 + ni * 32 + crow(r, h); const int hd = n >> 8, dv = n & 255;
            vgT[((size_t)(hd * 256 + chunk) * 256 + dv) * 64 + tk] = f2bf(acc[mi][ni][r]);
          }
      }
    } else if (nt < 64) {
      const int coff = (nt < 32) ? nt * 128 - 1024 : nt * 128 - 2048;
      const int mode = (nt < 32) ? 0 : (nt < 48 ? 1 : 2);
#pragma unroll
      for (int mi = 0; mi < 2; ++mi)
#pragma unroll
        for (int ni = 0; ni < 2; ++ni)
#pragma unroll
          for (int r = 0; r < 16; ++r) {
            float v = acc[mi][ni][r];
            if (mode == 1) v = v * sigmoidf_(v); else if (mode == 2) v = sigmoidf_(v);
            projt[(wm * 64 + mi * 32 + crow(r, h)) * NPROJ + coff + wn * 64 + ni * 32 + l31] = f2bf(v);
          }
    } else {
      if (wn == 0) {
#pragma unroll
        for (int mi = 0; mi < 2; ++mi)
#pragma unroll
          for (int r = 0; r < 16; ++r) (lrb + (size_t)row0 * 32)[(wm * 64 + mi * 32 + crow(r, h)) * 32 + l31] = acc[mi][0][r];
      }
    }
  }
}

DI float logsig16(float z) { return (fminf(z, 0.f) - __logf(1.f + __expf(-fabsf(z)))) * (1.f / 16.f); }

DI void phase_gla_prep(const Params& p, int g, char* smem, int bid, int nb) {
  float* lrs = (float*)smem;
  float* tot = lrs + 1024;
  const bf16_t* proj = (const bf16_t*)(p.ws + OFF_PROJ); const float* lrb = (const float*)(p.ws + OFF_LR);
  bf16_t* gq = (bf16_t*)(p.ws + OFF_GQ); bf16_t* gk = (bf16_t*)(p.ws + OFF_GK); bf16_t* gkt = (bf16_t*)(p.ws + OFF_GKT); float* ge = (float*)(p.ws + OFF_GE);
  const int tid = TID(), d = tid & 127, half = tid >> 7;
  for (int item = bid; item < 2048; item += nb) {
    const int c = item & 255, head = (item >> 8) & 3, dir = item >> 10, dd = head * 128 + d;
    __syncthreads();
#pragma unroll
    for (int i = 0; i < 4; ++i) { const int idx = tid + 256 * i; lrs[idx] = lrb[(size_t)(c * 64 + (idx >> 4)) * 32 + dir * 16 + (idx & 15)]; }
    const float* wgp = dir ? p.w_gate_b : p.w_gate_f;
    float wg[16];
#pragma unroll
    for (int r = 0; r < 16; ++r) wg[r] = wgp[r * 512 + dd];
    const float bg = (dir ? p.b_gate_b : p.b_gate_f)[dd];
    __syncthreads();
    float tsum = 0.f;
    for (int tt = 0; tt < 32; ++tt) {
      const float* l = lrs + (half * 32 + tt) * 16; float z = bg;
#pragma unroll
      for (int r = 0; r < 16; ++r) z += l[r] * wg[r];
      tsum += logsig16(z);
    }
    tot[half * 128 + d] = tsum;
    __syncthreads();
    const float t0 = tot[d], t1 = tot[128 + d], TOTAL = t0 + t1;
    float run = half ? t0 : 0.f;
    const size_t blk = (size_t)((dir * 4 + head) * 256 + c);
    bf16_t* kd = gkt + (blk * 128 + d) * 64 + half * 32;
#pragma unroll 1
    for (int q = 0; q < 4; ++q) {
      unsigned kp[4];
#pragma unroll
      for (int t8 = 0; t8 < 8; ++t8) {
        const int t = half * 32 + q * 8 + t8;
        const float* l = lrs + t * 16; float z = bg;
#pragma unroll
        for (int r = 0; r < 16; ++r) z += l[r] * wg[r];
        const float gv = logsig16(z);
        const float b = dir ? (TOTAL - run) : (run + gv);
        run += gv;
        const size_t tg = (size_t)c * 64 + t;
        const float qv = bf2f(proj[tg * NPROJ + 2048 + dd]), kv = bf2f(proj[tg * NPROJ + 2560 + dd]);
        const float qt = qv * __expf(b) * 0.08838834764831845f, kt = kv * __expf(-b);
        gq[(blk * 64 + t) * 128 + d] = f2bf(qt);
        const bf16_t kb = f2bf(kt);
        gk[(blk * 64 + t) * 128 + d] = kb;
        if (t8 & 1) kp[t8 >> 1] |= ((unsigned)kb) << 16; else kp[t8 >> 1] = kb;
      }
      u32x4 v = {kp[0], kp[1], kp[2], kp[3]}; *(u32x4*)(kd + 8 * q) = v;
    }
    if (half == 0) ge[blk * 128 + d] = __expf(TOTAL);
  }
}

DI void gla_scan_unit(const Params& p, int g, int u, char* smem) {
  const GroupInfo gi = group_info(p, g);
  bf16_t* St = (bf16_t*)smem;
  bf16_t* Am = St + 64 * 136;
  const int slice = u & 3, dir = (u >> 2) & 1, head = (u >> 3) & 3, seq = u >> 5;
  const int nchunk = gi.S >> 6, chunk0 = seq * nchunk;
  const int tid = TID(), lane = tid & 63, wave = tid >> 6, wi = wave >> 1, wd = wave & 1, h = lane >> 5, l31 = lane & 31;
  const bf16_t* gq = (const bf16_t*)(p.ws + OFF_GQ); const bf16_t* gk = (const bf16_t*)(p.ws + OFF_GK); const bf16_t* gkt = (const bf16_t*)(p.ws + OFF_GKT);
  const float* ge = (const float*)(p.ws + OFF_GE); const bf16_t* vgT = (const bf16_t*)(p.ws + OFF_VGT);
  bf16_t* od = (bf16_t*)gi.out + (size_t)dir * TOKG * 1024;
  __syncthreads();
  for (int i = tid; i < 64 * 136 / 2; i += 256) ((unsigned*)St)[i] = 0u;
  f32x16 Sacc[2];
#pragma unroll
  for (int t = 0; t < 2; ++t)
#pragma unroll
    for (int r = 0; r < 16; ++r) Sacc[t][r] = 0.f;
  __syncthreads();
  for (int step = 0; step < nchunk; ++step) {
    const int cgk = chunk0 + (dir ? nchunk - 1 - step : step);
    const size_t blk = (size_t)((dir * 4 + head) * 256 + cgk);
    const bf16_t* gq_c = gq + blk * 8192; const bf16_t* gk_c = gk + blk * 8192; const bf16_t* gkt_c = gkt + blk * 8192;
    const bf16_t* vt_c = vgT + ((size_t)(head * 256 + cgk) * 256 + slice * 64) * 64;
    const float* e_c = ge + blk * 128;
    bf16x8 qf[8], kf[8], vf[4];
#pragma unroll
    for (int s = 0; s < 8; ++s) { qf[s] = *(const bf16x8*)(gq_c + (wi * 32 + l31) * 128 + s * 16 + h * 8); kf[s] = *(const bf16x8*)(gk_c + (wd * 32 + l31) * 128 + s * 16 + h * 8); }
#pragma unroll
    for (int s = 0; s < 4; ++s) vf[s] = *(const bf16x8*)(vt_c + (wd * 32 + l31) * 64 + s * 16 + h * 8);
    f32x16 X;
#pragma unroll
    for (int r = 0; r < 16; ++r) X[r] = 0.f;
#pragma unroll
    for (int s = 0; s < 8; ++s) X = MFMA32(kf[s], qf[s], X);
    {
      const int gi_ = wi * 32 + l31;
#pragma unroll
      for (int q4 = 0; q4 < 4; ++q4) {
        float v[4];
#pragma unroll
        for (int e = 0; e < 4; ++e) { const int gj = wd * 32 + 8 * q4 + 4 * h + e; const bool keep = dir ? (gj >= gi_) : (gj <= gi_); v[e] = keep ? X[4 * q4 + e] : 0.f; }
        u32x2 o; o.x = pk_bf16(v[0], v[1]); o.y = pk_bf16(v[2], v[3]);
        *(u32x2*)(Am + gi_ * 72 + wd * 32 + 8 * q4 + 4 * h) = o;
      }
    }
    f32x16 o;
#pragma unroll
    for (int r = 0; r < 16; ++r) o[r] = 0.f;
#pragma unroll
    for (int s = 0; s < 8; ++s) { const bf16x8 sf = *(const bf16x8*)(St + (wd * 32 + l31) * 136 + s * 16 + h * 8); o = MFMA32(qf[s], sf, o); }
    __syncthreads();
#pragma unroll
    for (int s = 0; s < 4; ++s) { const bf16x8 af = *(const bf16x8*)(Am + (wi * 32 + l31) * 72 + s * 16 + h * 8); o = MFMA32(af, vf[s], o); }
    {
      const size_t tokb = (size_t)cgk * 64 + wi * 32;
#pragma unroll
      for (int r = 0; r < 16; ++r) od[(tokb + crow(r, h)) * 1024 + head * 256 + slice * 64 + wd * 32 + l31] = f2bf(o[r]);
    }
#pragma unroll
    for (int t = 0; t < 2; ++t) {
      const int dkb = 2 * wi + t;
#pragma unroll
      for (int s = 0; s < 4; ++s) { const bf16x8 ktf = *(const bf16x8*)(gkt_c + (dkb * 32 + l31) * 64 + s * 16 + h * 8); Sacc[t] = MFMA32(ktf, vf[s], Sacc[t]); }
#pragma unroll
      for (int q4 = 0; q4 < 4; ++q4) { const f32x4 ev = *(const f32x4*)(e_c + dkb * 32 + 8 * q4 + 4 * h);
#pragma unroll
        for (int e = 0; e < 4; ++e) Sacc[t][4 * q4 + e] *= ev[e]; }
    }
    __syncthreads();
#pragma unroll
    for (int t = 0; t < 2; ++t) {
      const int dkb = 2 * wi + t;
#pragma unroll
      for (int q4 = 0; q4 < 4; ++q4) {
        u32x2 w; w.x = pk_bf16(Sacc[t][4 * q4], Sacc[t][4 * q4 + 1]); w.y = pk_bf16(Sacc[t][4 * q4 + 2], Sacc[t][4 * q4 + 3]);
        *(u32x2*)(St + (wd * 32 + l31) * 136 + dkb * 32 + 8 * q4 + 4 * h) = w;
      }
    }
    __syncthreads();
  }
}

DI int t5_bucket(int rel) {
  const int n = rel < 0 ? -rel : rel; int b;
  if (n < 8) b = n; else b = 8 + (n >= 12) + (n >= 16) + (n >= 23) + (n >= 32) + (n >= 46) + (n >= 64) + (n >= 91);
  if (b > 15) b = 15;
  return b + (rel > 0 ? 16 : 0);
}

DI void attn_item(const Params& p, int g, int seq, int hd, int qt, int m, char* smem) {
  const GroupInfo gi = group_info(p, g);
  const int S = gi.S;
  const int sb = seq * S, q0 = qt * 128;
  bf16_t* Ks = (bf16_t*)smem;
  bf16_t* Vs = Ks + 2 * 32 * 72;
  float* tab = (float*)(Vs + 2 * 128 * 40);
  const bf16_t* proj = (const bf16_t*)(p.ws + OFF_PROJ); const bf16_t* vaT = (const bf16_t*)(p.ws + OFF_VAT); bf16_t* oa = (bf16_t*)(p.ws + (m ? OFF_OA2 : OFF_OA));
  const int tid = TID(), lane = tid & 63, wave = tid >> 6, h_ = lane >> 5, l31_ = lane & 31;
  __syncthreads();
  for (int i = tid; i < 257; i += 256) tab[i] = p.rel_bias[t5_bucket(i - 128) * 8 + hd] * LOG2E;
  const bf16_t* qrow = proj + (size_t)(sb + q0 + wave * 32 + l31_) * NPROJ + hd * 128 + h_ * 8;
  const int kr0 = tid >> 3, kc = (tid & 7) * 8;
  const int vr0 = tid >> 2, vc = (tid & 3) * 8;
  const bf16_t* vsrc = vaT + (size_t)(hd * 128 + vr0) * TOKG + sb + vc;
  const int nsteps = S >> 5;
  const int qw0 = q0 + wave * 32;
  {
    bf16x8 qf[4];
#pragma unroll
    for (int s = 0; s < 4; ++s) qf[s] = *(const bf16x8*)(qrow + m * 64 + s * 16);
    f32x16 O[4];
#pragma unroll
    for (int dt = 0; dt < 4; ++dt)
#pragma unroll
      for (int r = 0; r < 16; ++r) O[dt][r] = 0.f;
    float ls = 0.f;
    const bf16_t* ksrc = proj + (size_t)(sb + kr0) * NPROJ + 1024 + hd * 128 + m * 64 + kc;
    u32x4 rkA, rvA0, rvA1;
    auto load_tile = [&](int t, u32x4& k, u32x4& v0, u32x4& v1) __attribute__((always_inline)) {
      k = *(const u32x4*)(ksrc + (size_t)(t * 32) * NPROJ);
      v0 = *(const u32x4*)(vsrc + t * 32); v1 = *(const u32x4*)(vsrc + t * 32 + (size_t)64 * TOKG);
    };
    auto store_tile = [&](int buf, const u32x4& k, const u32x4& v0, const u32x4& v1) __attribute__((always_inline)) {
      bf16_t* Kn = Ks + buf * 32 * 72; bf16_t* Vn = Vs + buf * 128 * 40;
      *(u32x4*)(Kn + kr0 * 72 + kc) = k;
      *(u32x4*)(Vn + vr0 * 40 + vc) = v0; *(u32x4*)(Vn + (vr0 + 64) * 40 + vc) = v1;
    };
    auto compute = [&](int st, int buf) __attribute__((always_inline)) {
      const int k0 = st * 32, h = h_, l31 = l31_;
      const bf16_t* Kb = Ks + buf * 32 * 72; const bf16_t* Vb = Vs + buf * 128 * 40;
      const int rmin = k0 - (qw0 + 31), rmax = k0 + 31 - qw0;
      const int rel0 = k0 - (qw0 + l31) + 128;
      f32x16 X;
#pragma unroll
      for (int r = 0; r < 16; ++r) X[r] = 0.f;
#pragma unroll
      for (int s = 0; s < 4; ++s) { const bf16x8 kf = *(const bf16x8*)(Kb + l31 * 72 + s * 16 + h * 8); X = MFMA32(kf, qf[s], X); }
      if (rmin >= 128 || rmax <= -128) {
        const float bc = (rmin >= 128) ? tab[256] : tab[0];
#pragma unroll
        for (int r = 0; r < 16; ++r) X[r] = __builtin_amdgcn_exp2f(X[r] + bc);
      } else {
#pragma unroll
        for (int r = 0; r < 16; ++r) { int idx = rel0 + crow(r, h); idx = idx < 0 ? 0 : (idx > 256 ? 256 : idx); X[r] = __builtin_amdgcn_exp2f(X[r] + tab[idx]); }
      }
      float sum = 0.f;
#pragma unroll
      for (int r = 0; r < 16; ++r) sum += X[r];
      ls += sum;
      bf16x8 pf[2];
#pragma unroll
      for (int s2 = 0; s2 < 2; ++s2) {
        u32x4 w; w.x = pk_bf16(X[8 * s2], X[8 * s2 + 1]); w.y = pk_bf16(X[8 * s2 + 2], X[8 * s2 + 3]); w.z = pk_bf16(X[8 * s2 + 4], X[8 * s2 + 5]); w.w = pk_bf16(X[8 * s2 + 6], X[8 * s2 + 7]);
        pf[s2] = __builtin_bit_cast(bf16x8, w);
      }
#pragma unroll
      for (int s2 = 0; s2 < 2; ++s2)
#pragma unroll
        for (int dt = 0; dt < 4; ++dt) {
          const bf16x8 vf = *(const bf16x8*)(Vb + (dt * 32 + l31) * 40 + s2 * 16 + h * 8);
          O[dt] = MFMA32(pf[s2], vf, O[dt]);
        }
    };
    load_tile(0, rkA, rvA0, rvA1);
    __syncthreads();
    store_tile(0, rkA, rvA0, rvA1);
    load_tile(1, rkA, rvA0, rvA1);
    __syncthreads();
    for (int st = 0; st < nsteps; st += 2) {
      compute(st, 0);
      store_tile(1, rkA, rvA0, rvA1);
      if (st + 2 < nsteps) load_tile(st + 2, rkA, rvA0, rvA1);
      __syncthreads();
      compute(st + 1, 1);
      if (st + 2 < nsteps) store_tile(0, rkA, rvA0, rvA1);
      if (st + 3 < nsteps) load_tile(st + 3, rkA, rvA0, rvA1);
      __syncthreads();
    }
    ls = half_swap_sum(ls);
    int h = h_, l31 = l31_; OPAQUE(h); OPAQUE(l31);
    bf16_t* obase = oa + (size_t)(sb + q0 + wave * 32) * 1024 + hd * 128 + l31;
    const float inv = 1.f / ls;
#pragma unroll
    for (int r = 0; r < 16; ++r) {
      const float a = __shfl(inv, crow(r, h));
#pragma unroll
      for (int dt = 0; dt < 4; ++dt) obase[crow(r, h) * 1024 + dt * 32] = f2bf(O[dt][r] * a);
      asm volatile("" ::: "memory");
    }
  }
}

DI void phase_mixers(const Params& p, int gc, char* smem, int* s_item, int bid) {
  const int g = gc & 3;
  const GroupInfo gi = group_info(p, g);
  const int x = bid & 7;
  int* ctr = (int*)(p.ws + OFF_MISC) + gc * 8 + x;
  const int nscan_x = gi.nseq * 4, total = nscan_x + 256, nq = gi.S >> 7;
  for (;;) {
    __syncthreads();
    if (TID() == 0) *s_item = atomicAdd(ctr, 1);
    __syncthreads();
    const int item = *s_item;
    if (item >= total) break;
    if (item < nscan_x) gla_scan_unit(p, g, x * nscan_x + item, smem);
    else { const int ai = item - nscan_x, idx = ai >> 1; attn_item(p, g, idx / nq, x, idx % nq, ai & 1, smem); }
  }
}

DI void unpack8(const u32x4& v, float (&f)[8]) {
  f[0] = __uint_as_float(v.x << 16); f[1] = __uint_as_float(v.x & 0xffff0000u); f[2] = __uint_as_float(v.y << 16); f[3] = __uint_as_float(v.y & 0xffff0000u);
  f[4] = __uint_as_float(v.z << 16); f[5] = __uint_as_float(v.z & 0xffff0000u); f[6] = __uint_as_float(v.w << 16); f[7] = __uint_as_float(v.w & 0xffff0000u);
}
DI u32x4 pack8(const float (&f)[8]) { u32x4 v; v.x = pk_bf16(f[0], f[1]); v.y = pk_bf16(f[2], f[3]); v.z = pk_bf16(f[4], f[5]); v.w = pk_bf16(f[6], f[7]); return v; }

DI void phase_gla_norm(const Params& p, int g, int bid, int nb) {
  const GroupInfo gi = group_info(p, g);
  const bf16_t* of = (const bf16_t*)gi.out; const bf16_t* ob = of + (size_t)TOKG * 1024;
  const bf16_t* proj = (const bf16_t*)(p.ws + OFF_PROJ); bf16_t* dst = (bf16_t*)(p.ws + OFF_H);
  bf16_t* oa = (bf16_t*)(p.ws + OFF_OA); const bf16_t* oa2 = (const bf16_t*)(p.ws + OFF_OA2);
  const float lam = *(const float*)(p.ws + OFF_MISC + 1024);
  const int lane = TID() & 63, wave = TID() >> 6;
  float gn[16], sg[16];
#pragma unroll
  for (int e = 0; e < 16; ++e) { gn[e] = p.gla_norm_g[(lane & 15) * 16 + e]; sg[e] = p.subln_g[(lane & 7) * 16 + e] * 0.8f; }
  for (int tok = bid * 4 + wave; tok < TOKG; tok += nb * 4) {
    const size_t base = (size_t)tok * 1024 + lane * 16;
    const u32x4 f0 = *(const u32x4*)(of + base), f1 = *(const u32x4*)(of + base + 8), b0 = *(const u32x4*)(ob + base), b1 = *(const u32x4*)(ob + base + 8);
    const u32x4 g0 = *(const u32x4*)(proj + (size_t)tok * NPROJ + 3072 + lane * 16), g1 = *(const u32x4*)(proj + (size_t)tok * NPROJ + 3072 + lane * 16 + 8);
    const u32x4 a0 = *(const u32x4*)(oa + base), a1 = *(const u32x4*)(oa + base + 8), c0 = *(const u32x4*)(oa2 + base), c1 = *(const u32x4*)(oa2 + base + 8);
    float v[16], w[16], t[8], og[16];
    unpack8(f0, t);
#pragma unroll
    for (int e = 0; e < 8; ++e) v[e] = t[e];
    unpack8(f1, t);
#pragma unroll
    for (int e = 0; e < 8; ++e) v[8 + e] = t[e];
    unpack8(b0, t);
#pragma unroll
    for (int e = 0; e < 8; ++e) v[e] += t[e];
    unpack8(b1, t);
#pragma unroll
    for (int e = 0; e < 8; ++e) v[8 + e] += t[e];
    unpack8(g0, t);
#pragma unroll
    for (int e = 0; e < 8; ++e) og[e] = t[e];
    unpack8(g1, t);
#pragma unroll
    for (int e = 0; e < 8; ++e) og[8 + e] = t[e];
    unpack8(a0, t);
#pragma unroll
    for (int e = 0; e < 8; ++e) w[e] = t[e];
    unpack8(a1, t);
#pragma unroll
    for (int e = 0; e < 8; ++e) w[8 + e] = t[e];
    unpack8(c0, t);
#pragma unroll
    for (int e = 0; e < 8; ++e) w[e] -= lam * t[e];
    unpack8(c1, t);
#pragma unroll
    for (int e = 0; e < 8; ++e) w[8 + e] -= lam * t[e];
    float s1 = 0.f, s2 = 0.f;
#pragma unroll
    for (int e = 0; e < 16; ++e) { s1 += v[e] * v[e]; s2 += w[e] * w[e]; }
    s1 += xor_swz<1>(s1); s2 += xor_swz<1>(s2); s1 += xor_swz<2>(s1); s2 += xor_swz<2>(s2);
    s1 += xor_swz<4>(s1); s2 += xor_swz<4>(s2); s1 += xor_swz<8>(s1);
    const float r1 = rsqrtf(s1 * (1.f / 256.f) + EPSN), r2 = rsqrtf(s2 * (1.f / 128.f) + EPSN);
    float o1[8], o2[8];
#pragma unroll
    for (int e = 0; e < 8; ++e) { o1[e] = v[e] * r1 * gn[e] * og[e]; o2[e] = v[8 + e] * r1 * gn[8 + e] * og[8 + e]; }
    *(u32x4*)(dst + base) = pack8(o1); *(u32x4*)(dst + base + 8) = pack8(o2);
#pragma unroll
    for (int e = 0; e < 8; ++e) { o1[e] = w[e] * r2 * sg[e]; o2[e] = w[8 + e] * r2 * sg[8 + e]; }
    *(u32x4*)(oa + base) = pack8(o1); *(u32x4*)(oa + base + 8) = pack8(o2);
  }
}

DI void phase_merge(const Params& p, int g, char* smem, int bid, int nb) {
  bf16_t* As = (bf16_t*)smem; bf16_t* Bs = As + 128 * 72;
  const bf16_t* OA = (const bf16_t*)(p.ws + OFF_OA); const bf16_t* OB = (const bf16_t*)(p.ws + OFF_H);
  const bf16_t* WA = (const bf16_t*)(p.ws + OFF_WA); const bf16_t* WB = (const bf16_t*)(p.ws + OFF_WB);
  const bf16_t* proj = (const bf16_t*)(p.ws + OFF_PROJ); bf16_t* mg = (bf16_t*)(p.ws + OFF_GQ);
  TileSched ts(bid, nb, 8);
  int mt, nt;
  while (ts.next(mt, nt)) {
    f32x16 acc[2][2]; zero_acc(acc);
    gemm_tile<false>(OA + (size_t)mt * 128 * 1024, 1024, WA + (size_t)nt * 128 * 1024, 1024, 1024, acc, As, Bs);
    const int t_ = TID(); int wm = t_ >> 7, wn = (t_ >> 6) & 1, h = (t_ >> 5) & 1, l31 = t_ & 31;
    const bf16_t* pt = proj + (size_t)mt * 128 * NPROJ; bf16_t* mgt = mg + (size_t)mt * 128 * 1024;
#pragma unroll
    for (int mi = 0; mi < 2; ++mi)
#pragma unroll
      for (int ni = 0; ni < 2; ++ni)
#pragma unroll
        for (int r = 0; r < 16; ++r) {
          const int off = (wm * 64 + mi * 32 + crow(r, h)) * NPROJ + nt * 128 + wn * 64 + ni * 32 + l31;
          const float sga = bf2f(pt[off + 4096]), sgb = fmaxf(bf2f(pt[off + 5120]), 1e-20f);
          acc[mi][ni][r] *= sga / sgb;
          if ((r & 3) == 3) asm volatile("" ::: "memory");
        }
    gemm_tile<false>(OB + (size_t)mt * 128 * 1024, 1024, WB + (size_t)nt * 128 * 1024, 1024, 1024, acc, As, Bs);
    OPAQUE(wm); OPAQUE(wn); OPAQUE(h); OPAQUE(l31);
#pragma unroll
    for (int mi = 0; mi < 2; ++mi)
#pragma unroll
      for (int ni = 0; ni < 2; ++ni)
#pragma unroll
        for (int r = 0; r < 16; ++r) {
          const int rl = wm * 64 + mi * 32 + crow(r, h), cl = nt * 128 + wn * 64 + ni * 32 + l31;
          mgt[rl * 1024 + cl] = f2bf(acc[mi][ni][r] * fmaxf(bf2f(pt[rl * NPROJ + cl + 5120]), 1e-20f));
          if ((r & 3) == 3) asm volatile("" ::: "memory");
        }
  }
}

DI void phase_outproj(const Params& p, int g, char* smem, int bid, int nb) {
  const GroupInfo gi = group_info(p, g);
  bf16_t* As = (bf16_t*)smem; bf16_t* Bs = As + 128 * 72;
  const bf16_t* MG = (const bf16_t*)(p.ws + OFF_GQ); const bf16_t* WO = (const bf16_t*)(p.ws + OFF_WO);
  const float* mod = (const float*)(p.ws + OFF_MOD);
  TileSched ts(bid, nb, 8);
  int mt, nt;
  while (ts.next(mt, nt)) {
    f32x16 acc[2][2]; zero_acc(acc);
    gemm_tile<false>(MG + (size_t)mt * 128 * 1024, 1024, WO + (size_t)nt * 128 * 1024, 1024, 1024, acc, As, Bs);
    const int t_ = TID(); int wm = t_ >> 7, wn = (t_ >> 6) & 1, h = (t_ >> 5) & 1, l31 = t_ & 31;
    const int b = row_batch(gi, mt * 128);
    const float* xt = gi.x + (size_t)mt * 128 * 1024; float* ot = gi.out + (size_t)mt * 128 * 1024;
#pragma unroll
    for (int ni = 0; ni < 2; ++ni) {
      const int col = nt * 128 + wn * 64 + ni * 32 + l31;
      const float gt = mod[b * 6144 + 2048 + col];
#pragma unroll
      for (int mi = 0; mi < 2; ++mi) {
#pragma unroll
        for (int r = 0; r < 16; ++r) {
          const int off = (wm * 64 + mi * 32 + crow(r, h)) * 1024 + col;
          ot[off] = xt[off] + gt * acc[mi][ni][r];
        }
        asm volatile("" ::: "memory");
      }
    }
  }
}

DI void phase_up(const Params& p, int g, char* smem, int bid, int nb) {
  bf16_t* As = (bf16_t*)smem; bf16_t* Bs = As + 128 * 72;
  const bf16_t* H2 = (const bf16_t*)(p.ws + OFF_H); const bf16_t* WU = (const bf16_t*)(p.ws + OFF_WUP); bf16_t* U = (bf16_t*)(p.ws + OFF_PROJ);
  TileSched ts(bid, nb, 32);
  int mt, nt;
  while (ts.next(mt, nt)) {
    f32x16 acc[2][2]; zero_acc(acc);
    gemm_tile<false>(H2 + (size_t)mt * 128 * 1024, 1024, WU + (size_t)nt * 128 * 1024, 1024, 1024, acc, As, Bs);
    const int t_ = TID(); int wm = t_ >> 7, wn = (t_ >> 6) & 1, h = (t_ >> 5) & 1, l31 = t_ & 31;
#pragma unroll
    for (int mi = 0; mi < 2; ++mi)
#pragma unroll
      for (int ni = 0; ni < 2; ++ni)
#pragma unroll
        for (int r = 0; r < 16; ++r) {
          const float v = fmaxf(acc[mi][ni][r], 0.f);
          (U + (size_t)mt * 128 * 4096)[(wm * 64 + mi * 32 + crow(r, h)) * 4096 + nt * 128 + wn * 64 + ni * 32 + l31] = f2bf(v * v);
        }
  }
}

DI void phase_down(const Params& p, int g, char* smem, int bid, int nb) {
  const GroupInfo gi = group_info(p, g);
  bf16_t* As = (bf16_t*)smem; bf16_t* Bs = As + 128 * 72;
  const bf16_t* U = (const bf16_t*)(p.ws + OFF_PROJ); const bf16_t* WD = (const bf16_t*)(p.ws + OFF_WDN);
  const float* mod = (const float*)(p.ws + OFF_MOD);
  TileSched ts(bid, nb, 8);
  int mt, nt;
  while (ts.next(mt, nt)) {
    f32x16 acc[2][2]; zero_acc(acc);
    gemm_tile<false>(U + (size_t)mt * 128 * 4096, 4096, WD + (size_t)nt * 128 * 4096, 4096, 4096, acc, As, Bs);
    const int t_ = TID(); int wm = t_ >> 7, wn = (t_ >> 6) & 1, h = (t_ >> 5) & 1, l31 = t_ & 31;
    const int b = row_batch(gi, mt * 128);
    float* ot = gi.out + (size_t)mt * 128 * 1024;
#pragma unroll
    for (int ni = 0; ni < 2; ++ni) {
      const int col = nt * 128 + wn * 64 + ni * 32 + l31;
      const float gt = mod[b * 6144 + 5120 + col];
#pragma unroll
      for (int mi = 0; mi < 2; ++mi) {
#pragma unroll
        for (int r = 0; r < 16; ++r) {
          const int off = (wm * 64 + mi * 32 + crow(r, h)) * 1024 + col;
          ot[off] += gt * acc[mi][ni][r];
        }
        asm volatile("" ::: "memory");
      }
    }
  }
}


#define XB_TMO      128
#define XB_XCNT(j)  (256  + 64 * (j))
#define XB_XSUB(j)  (1280 + 64 * (j))
#define XB_XGEN(j)  (2304 + 64 * (j))
#define XB_TOP      3328
#define XB_TOPGEN   3392
#define XCD_BAR_WORDS 3456
#define XB_SPIN_CAP (1u << 20)
#define LAS __attribute__((address_space(3)))
DI unsigned xb_ld(unsigned* p) { return __hip_atomic_load(p, __ATOMIC_RELAXED, __HIP_MEMORY_SCOPE_AGENT); }
DI unsigned xb_add(unsigned* p, unsigned v) { return __hip_atomic_fetch_add(p, v, __ATOMIC_RELAXED, __HIP_MEMORY_SCOPE_AGENT); }
DI unsigned xb_xcc_id() { return (unsigned)__builtin_amdgcn_s_getreg((3 << 11) | 20) & 0xFu; }
#define XB_SPIN(cond, bar) do { unsigned _sp = 0; while (cond) { __builtin_amdgcn_s_sleep(1); \
    if ((++_sp & 255u) == 0u) { if (xb_ld(&(bar)[XB_TMO])) break; if (_sp > XB_SPIN_CAP) { atomicAdd(&(bar)[XB_TMO], 1u); break; } } } } while (0)
struct XcdBarrier { unsigned* bar; unsigned x; volatile LAS unsigned* st; };
DI XcdBarrier xcd_barrier_post(unsigned* bar, volatile LAS unsigned* st) {
  XcdBarrier b; b.bar = bar; b.x = xb_xcc_id(); b.st = st;
  if (TID() == 0) (void)xb_add(&bar[XB_XCNT(b.x)], 1u);
  return b;
}
DI void xcd_barrier_complete(unsigned* bar, unsigned x, unsigned& nloc, unsigned& nx) {
  const unsigned G = gridDim.x * gridDim.y * gridDim.z;
  unsigned sum, cnt, mine, sp = 0u;
  for (;;) {
    sum = 0u; cnt = 0u; mine = 0u;
#pragma unroll
    for (unsigned j = 0; j < 16; ++j) { const unsigned c = xb_ld(&bar[XB_XCNT(j)]); sum += c; cnt += (c > 0u) ? 1u : 0u; mine = (j == x) ? c : mine; }
    if (sum == G) break;
    __builtin_amdgcn_s_sleep(1);
    if ((++sp & 255u) == 0u) { if (xb_ld(&bar[XB_TMO])) break; if (sp > XB_SPIN_CAP) { atomicAdd(&bar[XB_TMO], 1u); break; } }
  }
  nloc = mine > 0u ? mine : 1u; nx = cnt > 0u ? cnt : 1u;
}
DI void xcd_barrier(const XcdBarrier& b) {
  asm volatile("s_waitcnt vmcnt(0)" ::: "memory");
  __syncthreads();
  if (TID() == 0) {
    unsigned* bar = b.bar;
    __builtin_amdgcn_s_waitcnt(0);
    unsigned nloc = b.st[0], nx = b.st[1];
    if (nloc == 0u) { xcd_barrier_complete(bar, b.x, nloc, nx); b.st[0] = nloc; b.st[1] = nx; }
    const unsigned old = xb_add(&bar[XB_XSUB(b.x)], 1u);
    const unsigned gen = old / nloc;
    if (old + 1u == (gen + 1u) * nloc) {
      __builtin_amdgcn_fence(__ATOMIC_RELEASE, "agent");
      asm volatile("s_waitcnt vmcnt(0)" ::: "memory");
      const unsigned og = xb_add(&bar[XB_TOP], 1u);
      const unsigned tg = og / nx;
      if (og + 1u == (tg + 1u) * nx) xb_add(&bar[XB_TOPGEN], 1u);
      else XB_SPIN(xb_ld(&bar[XB_TOPGEN]) == tg, bar);
      __builtin_amdgcn_fence(__ATOMIC_ACQUIRE, "agent");
      xb_add(&bar[XB_XGEN(b.x)], 1u);
      asm volatile("s_waitcnt vmcnt(0)" ::: "memory");
    } else {
      XB_SPIN(xb_ld(&bar[XB_XGEN(b.x)]) == gen, bar);
      __builtin_amdgcn_fence(__ATOMIC_ACQUIRE, "agent");
      asm volatile("s_waitcnt vmcnt(0)" ::: "memory");
    }
  }
  __syncthreads();
}

constexpr int SMEM_BYTES = 17 * 512 * 4 + 4 * 17 * 64 * 4;

DI void run_phase(const Params& p, int ph, int g, char* smem, int* s_item, int bid, int nb) {
  switch (ph) {
    case 0: phase_prologue(p, smem, bid, nb); break;
    case 1: { const GroupInfo gi = group_info(p, g); phase_modnorm(p, g, gi.x, p.norm1_g, 0, 1024, bid, nb); } break;
    case 2: phase_gemm1(p, g, smem, bid, nb); break;
    case 3: phase_gla_prep(p, g, smem, bid, nb); break;
    case 4: phase_mixers(p, g, smem, s_item, bid); break;
    case 5: phase_gla_norm(p, g, bid, nb); break;
    case 6: phase_merge(p, g, smem, bid, nb); break;
    case 7: phase_outproj(p, g, smem, bid, nb); break;
    case 8: { const GroupInfo gi = group_info(p, g); phase_modnorm(p, g, gi.out, p.norm2_g, 3072, 4096, bid, nb); } break;
    case 9: phase_up(p, g, smem, bid, nb); break;
    case 10: phase_down(p, g, smem, bid, nb); break;
    default: break;
  }
}

template <int PH>
__global__ void __launch_bounds__(256, 3) k_phase(Params p, int g) {
  __shared__ __attribute__((aligned(16))) char smem[SMEM_BYTES];
  __shared__ int s_item;
  TID_init();
  run_phase(p, PH, g, smem, &s_item, blockIdx.x, gridDim.x);
}
template <int PH> static void launch_phase(const Params& p, int g, hipStream_t stream) { k_phase<PH><<<512, 256, 0, stream>>>(p, g); }

#if ONE_LAUNCH
__global__ void __launch_bounds__(256, 3) k_mega(Params p) {
  __shared__ __attribute__((aligned(16))) char smem[SMEM_BYTES];
  __shared__ int s_item;
  __shared__ uint4 xb_words;
  cg::grid_group grid = cg::this_grid();
  const int bid = blockIdx.x, nb = gridDim.x;
  TID_init();
  if (threadIdx.x == 0) xb_words = make_uint4(0u, 0u, 0u, 0u);
  __syncthreads();
  (void)xcd_barrier_post((unsigned*)(p.ws + OFF_BAR), (volatile LAS unsigned*)&xb_words);
  auto seam = [&]() __attribute__((always_inline)) {
    XcdBarrier b; b.bar = (unsigned*)(p.ws + OFF_BAR); b.x = xb_xcc_id(); b.st = (volatile LAS unsigned*)&xb_words;
    xcd_barrier(b);
  };
  run_phase(p, 0, 0, smem, &s_item, bid, nb);
  if (p.ws == nullptr) grid.sync();
  seam();
#pragma unroll 1
  for (int g = 0; g < 3; ++g) {
#pragma unroll 1
    for (int ph = (g == 0 ? 1 : 2); ph <= 10; ++ph) {
      run_phase(p, ph, g, smem, &s_item, bid, nb);
      if (ph == 10 && g < 2) run_phase(p, 1, g + 1, smem, &s_item, bid, nb);
      if (!(g == 2 && ph == 10)) seam();
    }
  }
}
#endif

extern "C" void kernel_launch(void* const* d_in, const int* in_sizes, int n_in, void* d_out, int out_size, void* d_ws, size_t ws_size, hipStream_t stream) {
  Params p{};
  const float** pp = (const float**)&p;
  for (int i = 0; i < 27; ++i) pp[i] = (const float*)d_in[i];
  p.out = (float*)d_out;
  p.ws = (char*)d_ws;
  if (ws_size < WS_TOTAL) { fprintf(stderr, "workspace too small: %zu < %zu\n", ws_size, (size_t)WS_TOTAL); return; }
#if ONE_LAUNCH
  static int grid_blocks = 0;
  if (!grid_blocks) {
    int dev = 0, cus = 0, per_cu = 0;
    hipGetDevice(&dev);
    hipDeviceGetAttribute(&cus, hipDeviceAttributeMultiprocessorCount, dev);
    hipOccupancyMaxActiveBlocksPerMultiprocessor(&per_cu, k_mega, 256, 0);
    if (per_cu > 3) per_cu = 3;
    grid_blocks = cus * per_cu;
  }
  hipMemsetAsync((char*)d_ws + OFF_MISC, 0, 32768, stream);
  void* args[] = {&p};
  hipError_t e = hipLaunchCooperativeKernel((void*)k_mega, dim3(grid_blocks), dim3(256), args, 0, stream);
  if (e != hipSuccess) fprintf(stderr, "cooperative launch failed: %s (grid %d)\n", hipGetErrorString(e), grid_blocks);
#else
  hipMemsetAsync((char*)d_ws + OFF_MISC, 0, 32768, stream);
  launch_phase<0>(p, 0, stream);
  for (int g = 0; g < 3; ++g) {
    launch_phase<1>(p, g, stream); launch_phase<2>(p, g, stream); launch_phase<3>(p, g, stream); launch_phase<4>(p, g, stream); launch_phase<5>(p, g, stream);
    launch_phase<6>(p, g, stream); launch_phase<7>(p, g, stream); launch_phase<8>(p, g, stream); launch_phase<9>(p, g, stream); launch_phase<10>(p, g, stream);
  }
#endif
}
```

```cpp
#include <hip/hip_runtime.h>
#include <hip/hip_cooperative_groups.h>
#include <cstdint>
#include <cstdio>
namespace cg = cooperative_groups;

#define PROBE_MODE 0
#ifndef ONE_LAUNCH
#define ONE_LAUNCH 1
#endif

#define DI __device__ __forceinline__
typedef unsigned short bf16_t;
typedef short bf16x8 __attribute__((ext_vector_type(8)));
typedef float f32x16 __attribute__((ext_vector_type(16)));
typedef float f32x4 __attribute__((ext_vector_type(4)));
typedef float f32x2 __attribute__((ext_vector_type(2)));
typedef unsigned u32x4 __attribute__((ext_vector_type(4)));
typedef unsigned u32x2 __attribute__((ext_vector_type(2)));
typedef __bf16 bf16v2 __attribute__((ext_vector_type(2)));
#define OPAQUE(x) asm volatile("" : "+v"(x))
__device__ __forceinline__ int TID() { int t = threadIdx.x; asm volatile("" : "+v"(t)); return t; }
#define MFMA32(a, b, c) __builtin_amdgcn_mfma_f32_32x32x16_bf16((a), (b), (c), 0, 0, 0)

constexpr int TOKG = 16384;
constexpr int NPROJ = 5120;
constexpr int PQG = 1024, PKG = 1536, POG = 2048, PGA = 3072, PGB = 4096;
constexpr float EPSN = 1e-6f;
constexpr float LOG2E = 1.4426950408889634f;
constexpr float QSCALE = 0.125f * LOG2E;

constexpr size_t MiB = 1024 * 1024;
constexpr size_t OFF_WIN = 0;
constexpr size_t OFF_WA = OFF_WIN + (size_t)8320 * 1024 * 2;
constexpr size_t OFF_WB = OFF_WA + 2 * MiB;
constexpr size_t OFF_WO = OFF_WB + 2 * MiB;
constexpr size_t OFF_WUP = OFF_WO + 2 * MiB;
constexpr size_t OFF_WDN = OFF_WUP + 8 * MiB;
constexpr size_t OFF_MOD = OFF_WDN + 8 * MiB;
constexpr size_t OFF_MISC = OFF_MOD + 512 * 1024;
constexpr size_t OFF_BAR = OFF_MISC + 4096;
constexpr size_t OFF_H = OFF_MISC + 32768;
constexpr size_t OFF_PROJ = OFF_H + 32 * MiB;
constexpr size_t OFF_KBLK = OFF_PROJ + 160 * MiB;
constexpr size_t OFF_VAT = OFF_KBLK + 32 * MiB;
constexpr size_t OFF_VGT = OFF_VAT + 32 * MiB;
constexpr size_t OFF_LR = OFF_VGT + 32 * MiB;
constexpr size_t OFF_GQ = OFF_LR + 2 * MiB;
constexpr size_t OFF_GK = OFF_GQ + 32 * MiB;
constexpr size_t OFF_GKT = OFF_GK + 32 * MiB;
constexpr size_t OFF_GE = OFF_GKT + 32 * MiB;
constexpr size_t OFF_OA = OFF_GE + 1 * MiB;
constexpr size_t OFF_OA2 = OFF_OA + 32 * MiB;
constexpr size_t OFF_PO = OFF_OA2 + 32 * MiB;
constexpr size_t OFF_PL = OFF_PO + 16 * MiB;
constexpr size_t WS_TOTAL = OFF_PL + 256 * 1024;
constexpr int SPLIT_NS = 16, SPLIT_SP = 4;

struct Params {
  const float *x_prompt, *x_sample, *c_prompt, *c_sample, *rel_bias, *w_ada, *b_ada, *norm1_g, *w_in, *q_norm_g, *k_norm_g,
      *lam_q1, *lam_k1, *lam_q2, *lam_k2, *subln_g, *w_gate_f, *b_gate_f, *w_gate_b, *b_gate_b, *gla_norm_g, *w_branch_a,
      *w_branch_b, *w_out, *norm2_g, *w_up, *w_down;
  float* out;
  char* ws;
  int probe_mode; int pad_;
};

DI void lds_barrier() { asm volatile("s_waitcnt lgkmcnt(0)\n\ts_barrier" ::: "memory"); }
DI float bf2f(bf16_t v) { return __uint_as_float(((unsigned)v) << 16); }
DI unsigned pk_bf16(float lo, float hi) { f32x2 v = {lo, hi}; bf16v2 b = __builtin_convertvector(v, bf16v2); return __builtin_bit_cast(unsigned, b); }
DI bf16_t f2bf(float x) { return (bf16_t)(pk_bf16(x, 0.f) & 0xffffu); }
DI int crow(int r, int h) { return (r & 3) + 8 * (r >> 2) + 4 * h; }
DI float sigmoidf_(float x) { return 1.f / (1.f + __expf(-x)); }
DI int permpos(int t) { return (t & ~12) | ((t & 4) << 1) | ((t & 8) >> 1); }
DI float half_sum32(float v) {
  v += __shfl_xor(v, 1); v += __shfl_xor(v, 2); v += __shfl_xor(v, 4); v += __shfl_xor(v, 8); v += __shfl_xor(v, 16); return v;
}
DI void zero_acc(f32x16 (&acc)[2][2]) {
#pragma unroll
  for (int a = 0; a < 2; ++a)
#pragma unroll
    for (int b = 0; b < 2; ++b)
#pragma unroll
      for (int r = 0; r < 16; ++r) acc[a][b][r] = 0.f;
}

struct GroupInfo { int S, nseq, b0; const float* x; float* out; };
DI GroupInfo group_info(const Params& p, int g) {
  GroupInfo gi;
  if (g == 0) { gi.S = 16384; gi.nseq = 1; gi.b0 = 0; gi.x = p.x_prompt; }
  else { gi.S = 2048; gi.nseq = 8; gi.b0 = 1 + (g - 1) * 8; gi.x = p.x_sample + (size_t)(g - 1) * TOKG * 1024; }
  gi.out = p.out + (size_t)g * TOKG * 1024;
  return gi;
}
DI int row_batch(const GroupInfo& gi, int row) { return gi.b0 + (gi.nseq == 1 ? 0 : (row >> 11)); }

constexpr int GT_IMG = 128 * 72;
template <bool SWAP>
DI void gemm_tile(const bf16_t* __restrict__ A, int lda, const bf16_t* __restrict__ Bt, int ldb, int K, f32x16 (&acc)[2][2], bf16_t* As, bf16_t* Bs_unused) {
  (void)Bs_unused;
  const int tid = TID(), lane = tid & 63, wave = tid >> 6, wm = wave >> 1, wn = wave & 1;
  const int lr = tid >> 3, lc = (tid & 7) * 8;
  const bf16_t* ga = A + (size_t)lr * lda + lc;
  const bf16_t* gb = Bt + (size_t)lr * ldb + lc;
  u32x4 ra0[4], rb0[4], ra1[4], rb1[4];
  auto load_stage = [&](u32x4 (&ra)[4], u32x4 (&rb)[4], int t) __attribute__((always_inline)) {
#pragma unroll
    for (int i = 0; i < 4; ++i) { ra[i] = *(const u32x4*)(ga + (size_t)(32 * i) * lda + t * 64); rb[i] = *(const u32x4*)(gb + (size_t)(32 * i) * ldb + t * 64); }
  };
  auto write_stage = [&](const u32x4 (&ra)[4], const u32x4 (&rb)[4], int buf) __attribute__((always_inline)) {
    bf16_t* Ad = As + buf * 2 * GT_IMG; bf16_t* Bd = Ad + GT_IMG;
#pragma unroll
    for (int i = 0; i < 4; ++i) { *(u32x4*)(Ad + (lr + 32 * i) * 72 + lc) = ra[i]; *(u32x4*)(Bd + (lr + 32 * i) * 72 + lc) = rb[i]; }
  };
  const int fr = lane & 31, fk = (lane >> 5) * 8;
  const int pao = (wm * 64 + fr) * 72 + fk, pbo = GT_IMG + (wn * 64 + fr) * 72 + fk;
  auto frag_read = [&](bf16x8 (&f)[4], const bf16_t* pa, const bf16_t* pb, int so) __attribute__((always_inline)) {
    f[0] = *(const bf16x8*)(pa + so); f[1] = *(const bf16x8*)(pb + so); f[2] = *(const bf16x8*)(pb + 32 * 72 + so); f[3] = *(const bf16x8*)(pa + 32 * 72 + so);
  };
  auto mfma4 = [&](const bf16x8 (&f)[4]) __attribute__((always_inline)) {
    if (SWAP) {
      acc[0][0] = MFMA32(f[1], f[0], acc[0][0]); acc[0][1] = MFMA32(f[2], f[0], acc[0][1]);
      acc[1][0] = MFMA32(f[1], f[3], acc[1][0]); acc[1][1] = MFMA32(f[2], f[3], acc[1][1]);
    } else {
      acc[0][0] = MFMA32(f[0], f[1], acc[0][0]); acc[0][1] = MFMA32(f[0], f[2], acc[0][1]);
      acc[1][0] = MFMA32(f[3], f[1], acc[1][0]); acc[1][1] = MFMA32(f[3], f[2], acc[1][1]);
    }
  };
  auto step = [&](int buf, u32x4 (&ra)[4], u32x4 (&rb)[4], bool do_write, bool do_load, int tload) __attribute__((always_inline)) {
    const bf16_t* pa = As + buf * 2 * GT_IMG + pao; const bf16_t* pb = As + buf * 2 * GT_IMG + pbo;
    bf16_t* Ad = As + (buf ^ 1) * 2 * GT_IMG; bf16_t* Bd = Ad + GT_IMG;
    bf16x8 F0[4], F1[4];
    frag_read(F0, pa, pb, 0);
    __builtin_amdgcn_sched_barrier(0);
    frag_read(F1, pa, pb, 16);
    mfma4(F0);
    __builtin_amdgcn_sched_barrier(0);
    frag_read(F0, pa, pb, 32);
    mfma4(F1);
    if (do_write) {
#pragma unroll
      for (int i = 0; i < 4; ++i) *(u32x4*)(Ad + (lr + 32 * i) * 72 + lc) = ra[i];
    }
    __builtin_amdgcn_sched_barrier(0);
    frag_read(F1, pa, pb, 48);
    mfma4(F0);
    if (do_write) {
#pragma unroll
      for (int i = 0; i < 4; ++i) *(u32x4*)(Bd + (lr + 32 * i) * 72 + lc) = rb[i];
    }
    __builtin_amdgcn_sched_barrier(0);
    mfma4(F1);
    if (do_load) load_stage(ra, rb, tload);
    __builtin_amdgcn_sched_barrier(0);
  };
  const int nk = K >> 6;
  load_stage(ra0, rb0, 0); load_stage(ra1, rb1, 1);
  __syncthreads();
  write_stage(ra0, rb0, 0);
  load_stage(ra0, rb0, 2);
  __syncthreads();
  for (int kt = 0; kt < nk; kt += 2) {
    step(0, ra1, rb1, true, kt + 3 < nk, kt + 3);
    __syncthreads();
    step(1, ra0, rb0, kt + 2 < nk, kt + 4 < nk, kt + 4);
    __syncthreads();
  }
}

struct TileSched {
  int j, step, total, NT, xcd, simple;
  DI TileSched(int bid, int nb, int NT_) {
    NT = NT_;
    if ((nb & 7) == 0) { xcd = bid & 7; j = bid >> 3; step = nb >> 3; total = 16 * NT; simple = 0; }
    else { xcd = 0; j = bid; step = nb; total = 128 * NT; simple = 1; }
  }
  DI bool next(int& mt, int& nt) {
    if (j >= total) return false;
    if (simple) { mt = j & 127; nt = j >> 7; }
    else { const int half = j / (8 * NT), jj = j - half * 8 * NT; mt = xcd * 16 + half * 8 + (jj & 7); nt = jj >> 3; }
    j += step; return true;
  }
};

DI int win_src_col(int n) { return n < 6144 ? n : (n < 8192 ? n + 32 : (n < 8224 ? n - 2048 : -1)); }

DI void transpose_tile(const float* __restrict__ W, int ldw, bf16_t* __restrict__ Wt, int K, int kt, int nt, bool is_win, float* sm) {
  const int tid = TID(), c = tid & 63, r0 = tid >> 6;
  const int n = nt * 64 + c; const int src = is_win ? win_src_col(n) : n;
  __syncthreads();
#pragma unroll
  for (int i = 0; i < 16; ++i) { const int k = r0 + 4 * i; sm[k * 65 + c] = (src >= 0) ? W[(size_t)(kt * 64 + k) * ldw + src] : 0.f; }
  __syncthreads();
#pragma unroll
  for (int i = 0; i < 16; ++i) { const int nn = r0 + 4 * i; Wt[(size_t)(nt * 64 + nn) * K + kt * 64 + c] = f2bf(sm[c * 65 + nn]); }
}

DI void mod_item(const Params& p, int cgi, char* smem) {
  float* tab = (float*)smem;
  float* red = tab + 17 * 512;
  float* mod = (float*)(p.ws + OFF_MOD);
  const int tid = TID(), cl = tid & 63, kq = tid >> 6, col = cgi * 64 + cl;
  float acc[17];
#pragma unroll
  for (int b = 0; b < 17; ++b) acc[b] = 0.f;
  for (int pass = 0; pass < 2; ++pass) {
    __syncthreads();
    for (int i = tid; i < 17 * 512; i += 256) {
      const int b = i >> 9, k = pass * 512 + (i & 511);
      const float cv = (b == 0) ? p.c_prompt[k] : p.c_sample[(b - 1) * 1024 + k];
      tab[i] = cv / (1.f + __expf(-cv));
    }
    __syncthreads();
    for (int kk = 0; kk < 128; kk += 16) {
      float w[16];
#pragma unroll
      for (int u = 0; u < 16; ++u) w[u] = p.w_ada[(size_t)(pass * 512 + kq * 128 + kk + u) * 6144 + col];
#pragma unroll
      for (int u = 0; u < 16; ++u) {
        const int k = kq * 128 + kk + u;
#pragma unroll
        for (int b = 0; b < 17; ++b) acc[b] += tab[b * 512 + k] * w[u];
      }
    }
  }
  __syncthreads();
#pragma unroll
  for (int b = 0; b < 17; ++b) red[(kq * 17 + b) * 64 + cl] = acc[b];
  __syncthreads();
  for (int i = tid; i < 17 * 64; i += 256) {
    const int b = i >> 6, c = i & 63;
    const float s = red[(0 * 17 + b) * 64 + c] + red[(1 * 17 + b) * 64 + c] + red[(2 * 17 + b) * 64 + c] + red[(3 * 17 + b) * 64 + c];
    mod[b * 6144 + cgi * 64 + c] = s + p.b_ada[cgi * 64 + c];
  }
}

DI void phase_prologue(const Params& p, char* smem, int bid, int nb) {
  constexpr int N0 = 96, N1 = N0 + 2080, N2 = N1 + 256, N3 = N2 + 256, N4 = N3 + 256, N5 = N4 + 1024, N6 = N5 + 1024;
  for (int it = bid; it < N6 + 1; it += nb) {
    if (it < N0) mod_item(p, it, smem);
    else if (it < N1) { const int t = it - N0; transpose_tile(p.w_in, 8224, (bf16_t*)(p.ws + OFF_WIN), 1024, t & 15, t >> 4, true, (float*)smem); }
    else if (it < N2) { const int t = it - N1; transpose_tile(p.w_branch_a, 1024, (bf16_t*)(p.ws + OFF_WA), 1024, t & 15, t >> 4, false, (float*)smem); }
    else if (it < N3) { const int t = it - N2; transpose_tile(p.w_branch_b, 1024, (bf16_t*)(p.ws + OFF_WB), 1024, t & 15, t >> 4, false, (float*)smem); }
    else if (it < N4) { const int t = it - N3; transpose_tile(p.w_out, 1024, (bf16_t*)(p.ws + OFF_WO), 1024, t & 15, t >> 4, false, (float*)smem); }
    else if (it < N5) { const int t = it - N4; transpose_tile(p.w_up, 4096, (bf16_t*)(p.ws + OFF_WUP), 1024, t & 15, t >> 4, false, (float*)smem); }
    else if (it < N6) { const int t = it - N5; transpose_tile(p.w_down, 1024, (bf16_t*)(p.ws + OFF_WDN), 4096, t & 63, t >> 6, false, (float*)smem); }
    else {
      int* ctr = (int*)(p.ws + OFF_MISC);
      if (TID() < 64) ctr[TID()] = 0;
      if (TID() >= 64 && TID() < 128) {
        const int l = TID() - 64;
        float a = p.lam_q1[l] * p.lam_k1[l], b = p.lam_q2[l] * p.lam_k2[l];
#pragma unroll
        for (int m = 32; m >= 1; m >>= 1) { a += __shfl_xor(a, m); b += __shfl_xor(b, m); }
        if (l == 0) *(float*)(p.ws + OFF_MISC + 1024) = __expf(a) - __expf(b) + 0.2f;
      }
    }
  }
}

DI void phase_modnorm(const Params& p, int g, const float* xin, const float* gvec, int shift_off, int scale_off, int bid, int nb) {
  const GroupInfo gi = group_info(p, g);
  const float* mod = (const float*)(p.ws + OFF_MOD);
  bf16_t* hout = (bf16_t*)(p.ws + OFF_H);
  const int lane = TID() & 63, wave = TID() >> 6;
  for (int row = bid * 4 + wave; row < TOKG; row += nb * 4) {
    const int b = row_batch(gi, row);
    const float* xr = xin + (size_t)row * 1024;
    f32x4 v[4]; float ss = 0.f;
#pragma unroll
    for (int i = 0; i < 4; ++i) { v[i] = *(const f32x4*)(xr + i * 256 + lane * 4); ss += v[i][0] * v[i][0] + v[i][1] * v[i][1] + v[i][2] * v[i][2] + v[i][3] * v[i][3]; }
#pragma unroll
    for (int m = 32; m >= 1; m >>= 1) ss += __shfl_xor(ss, m);
    const float rs = rsqrtf(ss * (1.f / 1024.f) + EPSN);
#pragma unroll
    for (int i = 0; i < 4; ++i) {
      const int c = i * 256 + lane * 4;
      const f32x4 gv = *(const f32x4*)(gvec + c), sc = *(const f32x4*)(mod + b * 6144 + scale_off + c), sh = *(const f32x4*)(mod + b * 6144 + shift_off + c);
      f32x4 y;
#pragma unroll
      for (int e = 0; e < 4; ++e) y[e] = v[i][e] * rs * gv[e] * (1.f + sc[e]) + sh[e];
      u32x2 o; o.x = pk_bf16(y[0], y[1]); o.y = pk_bf16(y[2], y[3]);
      *(u32x2*)(hout + (size_t)row * 1024 + c) = o;
    }
  }
}

DI void phase_gemm1(const Params& p, int g, char* smem, int bid, int nb) {
  bf16_t* As = (bf16_t*)smem; bf16_t* Bs = As + 128 * 72;
  const bf16_t* H = (const bf16_t*)(p.ws + OFF_H); const bf16_t* W = (const bf16_t*)(p.ws + OFF_WIN);
  bf16_t* proj = (bf16_t*)(p.ws + OFF_PROJ); bf16_t* vaT = (bf16_t*)(p.ws + OFF_VAT); bf16_t* vgT = (bf16_t*)(p.ws + OFF_VGT); bf16_t* kblk = (bf16_t*)(p.ws + OFF_KBLK);
  float* lrb = (float*)(p.ws + OFF_LR);
  const int lane = TID() & 63, wave = TID() >> 6, wm_ = wave >> 1, wn_ = wave & 1, h_ = lane >> 5, l31_ = lane & 31;
  TileSched ts(bid, nb, 65);
  int mt, nt;
  while (ts.next(mt, nt)) {
    f32x16 acc[2][2]; zero_acc(acc);
    const bool swp = (nt >= 16 && nt < 24) || (nt >= 32 && nt < 40);
    const bf16_t* A = H + (size_t)mt * 128 * 1024; const bf16_t* B = W + (size_t)nt * 128 * 1024;
    if (swp) gemm_tile<true>(A, 1024, B, 1024, 1024, acc, As, Bs); else gemm_tile<false>(A, 1024, B, 1024, 1024, acc, As, Bs);
    int wm = wm_, wn = wn_, h = h_, l31 = l31_; OPAQUE(wm); OPAQUE(wn); OPAQUE(h); OPAQUE(l31);
    const int row0 = mt * 128;
    bf16_t* projt = proj + (size_t)row0 * NPROJ;
    if (nt < 16) {
      const float* gn = (nt < 8) ? p.q_norm_g : p.k_norm_g; const float sc = (nt < 8) ? QSCALE : 1.f;
      const float g0 = gn[l31] * sc, g1 = gn[32 + l31] * sc;
#pragma unroll
      for (int mi = 0; mi < 2; ++mi) {
        bf16_t* kt = kblk + ((size_t)((nt - 8) * 2 + wn) * 512 + ((row0 + wm * 64 + mi * 32) >> 5)) * 2048 + l31;
#pragma unroll
        for (int r = 0; r < 16; ++r) {
          const float a0 = acc[mi][0][r], a1 = acc[mi][1][r];
          const float ss = half_sum32(a0 * a0 + a1 * a1);
          const float rs = rsqrtf(ss * (1.f / 64.f) + EPSN);
          bf16_t* dst = (nt < 8) ? (projt + (wm * 64 + mi * 32 + crow(r, h)) * NPROJ + nt * 128 + wn * 64 + l31) : (kt + crow(r, h) * 64);
          dst[0] = f2bf(a0 * rs * g0); dst[32] = f2bf(a1 * rs * g1);
        }
      }
    } else if (nt < 24) {
#pragma unroll
      for (int mi = 0; mi < 2; ++mi) {
        const int tok = row0 + wm * 64 + mi * 32 + l31, pp = permpos(tok) & 31, tile = tok >> 5;
#pragma unroll
        for (int ni = 0; ni < 2; ++ni)
#pragma unroll
          for (int r = 0; r < 16; ++r) {
            const int n = (nt - 16) * 128 + wn * 64 + ni * 32 + crow(r, h); const int hd = n >> 7, dv = n & 127;
            vaT[((size_t)(hd * 512 + tile) * 128 + dv) * 32 + pp] = f2bf(acc[mi][ni][r]);
          }
      }
    } else if (nt < 40 && nt >= 32) {
#pragma unroll
      for (int mi = 0; mi < 2; ++mi) {
        const int tok = row0 + wm * 64 + mi * 32 + l31, chunk = tok >> 6, tk = tok & 63;
#pragma unroll
        for (int ni = 0; ni < 2; ++ni)
#pragma unroll
          for (int r = 0; r < 16; ++r) {
            const int n = (nt - 32) * 128 + wn * 64 + ni * 32 + crow(r, h); const int hd = n >> 8, dv = n & 255;
            vgT[((size_t)(hd * 256 + chunk) * 256 + dv) * 64 + tk] = f2bf(acc[mi][ni][r]);
          }
      }
    } else if (nt < 64) {
      const int coff = (nt < 32) ? nt * 128 - 2048 : nt * 128 - 3072;
      const int mode = (nt < 32) ? 0 : (nt < 48 ? 1 : 2);
#pragma unroll
      for (int mi = 0; mi < 2; ++mi)
#pragma unroll
        for (int ni = 0; ni < 2; ++ni)
#pragma unroll
          for (int r = 0; r < 16; ++r) {
            float v = acc[mi][ni][r];
            if (mode == 1) v = v * sigmoidf_(v); else if (mode == 2) v = sigmoidf_(v);
            projt[(wm * 64 + mi * 32 + crow(r, h)) * NPROJ + coff + wn * 64 + ni * 32 + l31] = f2bf(v);
          }
    } else {
      if (wn == 0) {
#pragma unroll
        for (int mi = 0; mi < 2; ++mi)
#pragma unroll
          for (int r = 0; r < 16; ++r) (lrb + (size_t)row0 * 32)[(wm * 64 + mi * 32 + crow(r, h)) * 32 + l31] = acc[mi][0][r];
      }
    }
  }
}

DI float logsig16(float z) { return (fminf(z, 0.f) - __logf(1.f + __expf(-fabsf(z)))) * (1.f / 16.f); }

DI void phase_gla_prep(const Params& p, int g, char* smem, int bid, int nb) {
  float* lrs = (float*)smem;
  float* tot = lrs + 1024;
  const bf16_t* proj = (const bf16_t*)(p.ws + OFF_PROJ); const float* lrb = (const float*)(p.ws + OFF_LR);
  bf16_t* gq = (bf16_t*)(p.ws + OFF_GQ); bf16_t* gk = (bf16_t*)(p.ws + OFF_GK); bf16_t* gkt = (bf16_t*)(p.ws + OFF_GKT); float* ge = (float*)(p.ws + OFF_GE);
  const int tid = TID(), d = tid & 127, half = tid >> 7;
  for (int item = bid; item < 2048; item += nb) {
    const int c = item & 255, head = (item >> 8) & 3, dir = item >> 10, dd = head * 128 + d;
    __syncthreads();
#pragma unroll
    for (int i = 0; i < 4; ++i) { const int idx = tid + 256 * i; lrs[idx] = lrb[(size_t)(c * 64 + (idx >> 4)) * 32 + dir * 16 + (idx & 15)]; }
    const float* wgp = dir ? p.w_gate_b : p.w_gate_f;
    float wg[16];
#pragma unroll
    for (int r = 0; r < 16; ++r) wg[r] = wgp[r * 512 + dd];
    const float bg = (dir ? p.b_gate_b : p.b_gate_f)[dd];
    __syncthreads();
    float tsum = 0.f;
    for (int tt = 0; tt < 32; ++tt) {
      const float* l = lrs + (half * 32 + tt) * 16; float z = bg;
#pragma unroll
      for (int r = 0; r < 16; ++r) z += l[r] * wg[r];
      tsum += logsig16(z);
    }
    tot[half * 128 + d] = tsum;
    __syncthreads();
    const float t0 = tot[d], t1 = tot[128 + d], TOTAL = t0 + t1;
    float run = half ? t0 : 0.f;
    const size_t blk = (size_t)((dir * 4 + head) * 256 + c);
    unsigned ktp[16];
#pragma unroll
    for (int tt = 0; tt < 32; ++tt) {
      const int t = half * 32 + tt;
      const float* l = lrs + t * 16; float z = bg;
#pragma unroll
      for (int r = 0; r < 16; ++r) z += l[r] * wg[r];
      const float gv = logsig16(z);
      const float b = dir ? (TOTAL - run) : (run + gv);
      run += gv;
      const size_t tg = (size_t)c * 64 + t;
      const float qv = bf2f(proj[tg * NPROJ + PQG + dd]), kv = bf2f(proj[tg * NPROJ + PKG + dd]);
      const float qt = qv * __expf(b) * 0.08838834764831845f, kt = kv * __expf(-b);
      gq[(blk * 64 + t) * 128 + d] = f2bf(qt);
      const bf16_t kb = f2bf(kt);
      gk[(blk * 64 + t) * 128 + d] = kb;
      if (tt & 1) ktp[tt >> 1] |= ((unsigned)kb) << 16; else ktp[tt >> 1] = kb;
    }
    bf16_t* kd = gkt + (blk * 128 + d) * 64 + half * 32;
#pragma unroll
    for (int q = 0; q < 4; ++q) { u32x4 v = {ktp[4 * q], ktp[4 * q + 1], ktp[4 * q + 2], ktp[4 * q + 3]}; *(u32x4*)(kd + 8 * q) = v; }
    if (half == 0) ge[blk * 128 + d] = __expf(TOTAL);
  }
}

DI void gla_scan_unit(const Params& p, int g, int u, char* smem) {
  const GroupInfo gi = group_info(p, g);
  bf16_t* St = (bf16_t*)smem;
  bf16_t* Am = St + 64 * 136;
  const int slice = u & 3, dir = (u >> 2) & 1, head = (u >> 3) & 3, seq = u >> 5;
  const int nchunk = gi.S >> 6, chunk0 = seq * nchunk;
  const int tid = TID(), lane = tid & 63, wave = tid >> 6, wi = wave >> 1, wd = wave & 1, h = lane >> 5, l31 = lane & 31;
  const bf16_t* gq = (const bf16_t*)(p.ws + OFF_GQ); const bf16_t* gk = (const bf16_t*)(p.ws + OFF_GK); const bf16_t* gkt = (const bf16_t*)(p.ws + OFF_GKT);
  const float* ge = (const float*)(p.ws + OFF_GE); const bf16_t* vgT = (const bf16_t*)(p.ws + OFF_VGT);
  bf16_t* od = (bf16_t*)gi.out + (size_t)dir * TOKG * 1024;
  __syncthreads();
  for (int i = tid; i < 64 * 136 / 2; i += 256) ((unsigned*)St)[i] = 0u;
  f32x16 Sacc[2];
#pragma unroll
  for (int t = 0; t < 2; ++t)
#pragma unroll
    for (int r = 0; r < 16; ++r) Sacc[t][r] = 0.f;
  __syncthreads();
  auto blk_of = [&](int step) __attribute__((always_inline)) { return (size_t)((dir * 4 + head) * 256 + chunk0 + (dir ? nchunk - 1 - step : step)); };
  bf16x8 qf[8], kf[8];
  {
    const size_t blk = blk_of(0);
#pragma unroll
    for (int s = 0; s < 8; ++s) { qf[s] = *(const bf16x8*)(gq + blk * 8192 + (wi * 32 + l31) * 128 + s * 16 + h * 8); kf[s] = *(const bf16x8*)(gk + blk * 8192 + (wd * 32 + l31) * 128 + s * 16 + h * 8); }
  }
  for (int step = 0; step < nchunk; ++step) {
    const int cgk = chunk0 + (dir ? nchunk - 1 - step : step);
    const size_t blk = (size_t)((dir * 4 + head) * 256 + cgk);
    const size_t blkn = blk_of(step + 1 < nchunk ? step + 1 : step);
    const bf16_t* gkt_c = gkt + blk * 8192;
    const bf16_t* vt_c = vgT + ((size_t)(head * 256 + cgk) * 256 + slice * 64) * 64;
    const float* e_c = ge + blk * 128;
    bf16x8 vf[4], ktf[2][4]; f32x4 ev[2][4];
#pragma unroll
    for (int s = 0; s < 4; ++s) vf[s] = *(const bf16x8*)(vt_c + (wd * 32 + l31) * 64 + s * 16 + h * 8);
#pragma unroll
    for (int t = 0; t < 2; ++t)
#pragma unroll
      for (int s = 0; s < 4; ++s) ktf[t][s] = *(const bf16x8*)(gkt_c + ((2 * wi + t) * 32 + l31) * 64 + s * 16 + h * 8);
    f32x16 X;
#pragma unroll
    for (int r = 0; r < 16; ++r) X[r] = 0.f;
#pragma unroll
    for (int s = 0; s < 8; ++s) X = MFMA32(kf[s], qf[s], X);
    __builtin_amdgcn_sched_barrier(0);
#pragma unroll
    for (int s = 0; s < 8; ++s) kf[s] = *(const bf16x8*)(gk + blkn * 8192 + (wd * 32 + l31) * 128 + s * 16 + h * 8);
    {
      const int gi_ = wi * 32 + l31;
#pragma unroll
      for (int q4 = 0; q4 < 4; ++q4) {
        float v[4];
#pragma unroll
        for (int e = 0; e < 4; ++e) { const int gj = wd * 32 + 8 * q4 + 4 * h + e; const bool keep = dir ? (gj >= gi_) : (gj <= gi_); v[e] = keep ? X[4 * q4 + e] : 0.f; }
        u32x2 o; o.x = pk_bf16(v[0], v[1]); o.y = pk_bf16(v[2], v[3]);
        *(u32x2*)(Am + gi_ * 72 + wd * 32 + 8 * q4 + 4 * h) = o;
      }
    }
    f32x16 o;
#pragma unroll
    for (int r = 0; r < 16; ++r) o[r] = 0.f;
#pragma unroll
    for (int s = 0; s < 8; ++s) { const bf16x8 sf = *(const bf16x8*)(St + (wd * 32 + l31) * 136 + s * 16 + h * 8); o = MFMA32(qf[s], sf, o); }
    __builtin_amdgcn_sched_barrier(0);
#pragma unroll
    for (int s = 0; s < 8; ++s) qf[s] = *(const bf16x8*)(gq + blkn * 8192 + (wi * 32 + l31) * 128 + s * 16 + h * 8);
    lds_barrier();
#pragma unroll
    for (int t = 0; t < 2; ++t)
#pragma unroll
      for (int q4 = 0; q4 < 4; ++q4) ev[t][q4] = *(const f32x4*)(e_c + (2 * wi + t) * 32 + 8 * q4 + 4 * h);
#pragma unroll
    for (int s = 0; s < 4; ++s) { const bf16x8 af = *(const bf16x8*)(Am + (wi * 32 + l31) * 72 + s * 16 + h * 8); o = MFMA32(af, vf[s], o); }
    {
      const size_t tokb = (size_t)cgk * 64 + wi * 32;
#pragma unroll
      for (int r = 0; r < 16; ++r) od[(tokb + crow(r, h)) * 1024 + head * 256 + slice * 64 + wd * 32 + l31] = f2bf(o[r]);
    }
#pragma unroll
    for (int t = 0; t < 2; ++t) {
#pragma unroll
      for (int s = 0; s < 4; ++s) Sacc[t] = MFMA32(ktf[t][s], vf[s], Sacc[t]);
#pragma unroll
      for (int q4 = 0; q4 < 4; ++q4)
#pragma unroll
        for (int e = 0; e < 4; ++e) Sacc[t][4 * q4 + e] *= ev[t][q4][e];
    }
    lds_barrier();
#pragma unroll
    for (int t = 0; t < 2; ++t) {
      const int dkb = 2 * wi + t;
#pragma unroll
      for (int q4 = 0; q4 < 4; ++q4) {
        u32x2 w; w.x = pk_bf16(Sacc[t][4 * q4], Sacc[t][4 * q4 + 1]); w.y = pk_bf16(Sacc[t][4 * q4 + 2], Sacc[t][4 * q4 + 3]);
        *(u32x2*)(St + (wd * 32 + l31) * 136 + dkb * 32 + 8 * q4 + 4 * h) = w;
      }
    }
    lds_barrier();
  }
}

DI int t5_bucket(int rel) {
  const int n = rel < 0 ? -rel : rel; int b;
  if (n < 8) b = n; else b = 8 + (n >= 12) + (n >= 16) + (n >= 23) + (n >= 32) + (n >= 46) + (n >= 64) + (n >= 91);
  if (b > 15) b = 15;
  return b + (rel > 0 ? 16 : 0);
}

DI void attn_item(const Params& p, int g, int seq, int hd, int qt, int m, char* smem, int split_j, int sub) {
  const GroupInfo gi = group_info(p, g);
  const int S = gi.S;
  const int sb = seq * S, q0 = qt * 128;
  bf16_t* Ks = (bf16_t*)smem;
  bf16_t* Vs = Ks + 4 * 32 * 72;
  float* tab = (float*)(Vs + 4 * 128 * 40);
  const bf16_t* proj = (const bf16_t*)(p.ws + OFF_PROJ); const bf16_t* vaT = (const bf16_t*)(p.ws + OFF_VAT); bf16_t* oa = (bf16_t*)(p.ws + (m ? OFF_OA2 : OFF_OA));
  const int tid = TID(), lane = tid & 63, wave = __builtin_amdgcn_readfirstlane(tid >> 6), h_ = lane >> 5, l31_ = lane & 31;
  __syncthreads();
  for (int i = tid; i < 257; i += 256) tab[i] = p.rel_bias[t5_bucket(i - 128) * 8 + hd] * LOG2E;
  const float cneg = p.rel_bias[15 * 8 + hd] * LOG2E, cpos = p.rel_bias[31 * 8 + hd] * LOG2E;
  const bf16_t* qrow = proj + (size_t)(sb + q0 + wave * 32 + l31_) * NPROJ + hd * 128 + h_ * 8;
  const int kr0 = tid >> 3, kc = (tid & 7) * 8;
  const int vr0 = tid >> 2, vc = (tid & 3) * 8;
  const bf16_t* vsrc = vaT + (size_t)(hd * 512 + (sb >> 5)) * 4096 + tid * 8;
  const int npairs = (split_j < 0) ? (S >> 6) : (S >> 6) / SPLIT_SP;
  const int tbase = (split_j < 0) ? 0 : split_j * npairs * 2;
  const int qw0 = q0 + wave * 32;
  bf16x8 qf[4];
#pragma unroll
  for (int s = 0; s < 4; ++s) qf[s] = *(const bf16x8*)(qrow + m * 64 + s * 16);
  f32x16 O[4];
#pragma unroll
  for (int dt = 0; dt < 4; ++dt)
#pragma unroll
    for (int r = 0; r < 16; ++r) O[dt][r] = 0.f;
  f32x2 ls2 = {0.f, 0.f};
  int region = 0;
  const bf16_t* ksrc = (const bf16_t*)(p.ws + OFF_KBLK) + (size_t)((hd * 2 + m) * 512 + (sb >> 5)) * 2048 + tid * 8;
  u32x4 rkA, rvA0, rvA1, rkB, rvB0, rvB1;
  auto load_tile = [&](int t, u32x4& k, u32x4& v0, u32x4& v1) __attribute__((always_inline)) {
    k = *(const u32x4*)(ksrc + (size_t)(tbase + t) * 2048);
    v0 = *(const u32x4*)(vsrc + (size_t)(tbase + t) * 4096); v1 = *(const u32x4*)(vsrc + (size_t)(tbase + t) * 4096 + 2048);
  };
  auto store_tile = [&](int buf, const u32x4& k, const u32x4& v0, const u32x4& v1) __attribute__((always_inline)) {
    bf16_t* Kn = Ks + buf * 32 * 72; bf16_t* Vn = Vs + buf * 128 * 40;
    *(u32x4*)(Kn + kr0 * 72 + kc) = k;
    *(u32x4*)(Vn + vr0 * 40 + vc) = v0; *(u32x4*)(Vn + (vr0 + 64) * 40 + vc) = v1;
  };
  auto rescale = [&](float f) __attribute__((always_inline)) {
#pragma unroll
    for (int dt = 0; dt < 4; ++dt)
#pragma unroll
      for (int r = 0; r < 16; ++r) O[dt][r] *= f;
    ls2 *= f;
  };
  auto compute = [&](int st, int buf) __attribute__((always_inline)) {
    const int k0 = (tbase + st) * 32, h = h_, l31 = l31_;
    const bf16_t* Kb = Ks + buf * 32 * 72; const bf16_t* Vb = Vs + buf * 128 * 40;
    const int rmin = k0 - (qw0 + 31), rmax = k0 + 31 - qw0;
    const bool farL = rmax <= -128, farR = rmin >= 128;
    if (!farL && region == 0) { rescale(__builtin_amdgcn_exp2f(cneg)); region = 1; }
    if (farR && region == 1) { rescale(__builtin_amdgcn_exp2f(-cpos)); region = 2; }
    bf16x8 kf[4], vf[2][4];
#pragma unroll
    for (int s = 0; s < 4; ++s) kf[s] = *(const bf16x8*)(Kb + l31 * 72 + s * 16 + h * 8);
#pragma unroll
    for (int s2 = 0; s2 < 2; ++s2)
#pragma unroll
      for (int dt = 0; dt < 4; ++dt) vf[s2][dt] = *(const bf16x8*)(Vb + (dt * 32 + l31) * 40 + s2 * 16 + h * 8);
    __builtin_amdgcn_sched_barrier(0);
    f32x16 X;
#pragma unroll
    for (int r = 0; r < 16; ++r) X[r] = 0.f;
#pragma unroll
    for (int s = 0; s < 4; ++s) X = MFMA32(kf[s], qf[s], X);
    if (farL || farR) {
#pragma unroll
      for (int r = 0; r < 16; ++r) X[r] = __builtin_amdgcn_exp2f(X[r]);
    } else {
      const int rel0 = k0 - (qw0 + l31) + 128;
#pragma unroll
      for (int r = 0; r < 16; ++r) { int idx = rel0 + crow(r, h); idx = idx < 0 ? 0 : (idx > 256 ? 256 : idx); X[r] = __builtin_amdgcn_exp2f(X[r] + tab[idx]); }
    }
    bf16x8 pf[2];
#pragma unroll
    for (int s2 = 0; s2 < 2; ++s2) {
      u32x4 w; w.x = pk_bf16(X[8 * s2], X[8 * s2 + 1]); w.y = pk_bf16(X[8 * s2 + 2], X[8 * s2 + 3]); w.z = pk_bf16(X[8 * s2 + 4], X[8 * s2 + 5]); w.w = pk_bf16(X[8 * s2 + 6], X[8 * s2 + 7]);
      ls2 += (f32x2){X[8 * s2], X[8 * s2 + 1]}; ls2 += (f32x2){X[8 * s2 + 2], X[8 * s2 + 3]};
      ls2 += (f32x2){X[8 * s2 + 4], X[8 * s2 + 5]}; ls2 += (f32x2){X[8 * s2 + 6], X[8 * s2 + 7]};
      pf[s2] = __builtin_bit_cast(bf16x8, w);
    }
#pragma unroll
    for (int s2 = 0; s2 < 2; ++s2)
#pragma unroll
      for (int dt = 0; dt < 4; ++dt) O[dt] = MFMA32(pf[s2], vf[s2][dt], O[dt]);
  };
  load_tile(0, rkA, rvA0, rvA1);
  load_tile(1, rkB, rvB0, rvB1);
  __syncthreads();
  store_tile(0, rkA, rvA0, rvA1);
  store_tile(1, rkB, rvB0, rvB1);
  __syncthreads();
  for (int it = 0; it < npairs; ++it) {
    const int set = it & 1;
    if (it + 1 < npairs) { load_tile(2 * it + 2, rkA, rvA0, rvA1); load_tile(2 * it + 3, rkB, rvB0, rvB1); }
    compute(2 * it, 2 * set);
    compute(2 * it + 1, 2 * set + 1);
    if (it + 1 < npairs) { store_tile(2 * (set ^ 1), rkA, rvA0, rvA1); store_tile(2 * (set ^ 1) + 1, rkB, rvB0, rvB1); }
    __syncthreads();
  }
  if (split_j >= 0) {
    if (region == 0) rescale(__builtin_amdgcn_exp2f(cneg));
    else if (region == 2) rescale(__builtin_amdgcn_exp2f(cpos));
  }
  float ls = ls2.x + ls2.y;
  ls += __shfl_xor(ls, 32);
  int h = h_, l31 = l31_; OPAQUE(h); OPAQUE(l31);
  if (split_j >= 0) {
    bf16_t* po = (bf16_t*)(p.ws + OFF_PO) + (size_t)sub * 16384 + (wave * 32) * 128 + l31;
    float* pl = (float*)(p.ws + OFF_PL) + sub * 128 + wave * 32;
    if (h == 0) pl[l31] = ls;
#pragma unroll
    for (int r = 0; r < 16; ++r) {
#pragma unroll
      for (int dt = 0; dt < 4; ++dt) po[crow(r, h) * 128 + dt * 32] = f2bf(O[dt][r]);
      asm volatile("" ::: "memory");
    }
    return;
  }
  bf16_t* obase = oa + (size_t)(sb + q0 + wave * 32) * 1024 + hd * 128 + l31;
  const float inv = 1.f / ls;
#pragma unroll
  for (int r = 0; r < 16; ++r) {
    const float a = __shfl(inv, crow(r, h));
#pragma unroll
    for (int dt = 0; dt < 4; ++dt) obase[crow(r, h) * 1024 + dt * 32] = f2bf(O[dt][r] * a);
    asm volatile("" ::: "memory");
  }
}

DI void phase_mixers(const Params& p, int gc, char* smem, int* s_item, int bid) {
  const int g = gc & 3;
  const GroupInfo gi = group_info(p, g);
  const int x = bid & 7;
  int* ctr = (int*)(p.ws + OFF_MISC) + gc * 8 + x;
  const int nsplit = (gi.nseq == 1) ? SPLIT_NS : 0;
  const int nreg = 256 - nsplit;
  const int nscan_x = gi.nseq * 4, total = nscan_x + nreg + nsplit * SPLIT_SP, nq = gi.S >> 7;
  for (;;) {
    __syncthreads();
    if (TID() == 0) *s_item = atomicAdd(ctr, 1);
    __syncthreads();
    const int item = *s_item;
    if (item >= total) break;
    if (item < nscan_x) gla_scan_unit(p, g, x * nscan_x + item, smem);
    else if (item < nscan_x + nreg) { const int ai = item - nscan_x, idx = ai >> 1; attn_item(p, g, idx / nq, x, idx % nq, ai & 1, smem, -1, 0); }
    else { const int sidx = item - nscan_x - nreg, ai = nreg + sidx / SPLIT_SP, idx = ai >> 1; attn_item(p, g, idx / nq, x, idx % nq, ai & 1, smem, sidx % SPLIT_SP, x * 64 + sidx); }
  }
}

DI void unpack8(const u32x4& v, float (&f)[8]) {
  f[0] = __uint_as_float(v.x << 16); f[1] = __uint_as_float(v.x & 0xffff0000u); f[2] = __uint_as_float(v.y << 16); f[3] = __uint_as_float(v.y & 0xffff0000u);
  f[4] = __uint_as_float(v.z << 16); f[5] = __uint_as_float(v.z & 0xffff0000u); f[6] = __uint_as_float(v.w << 16); f[7] = __uint_as_float(v.w & 0xffff0000u);
}
DI u32x4 pack8(const float (&f)[8]) { u32x4 v; v.x = pk_bf16(f[0], f[1]); v.y = pk_bf16(f[2], f[3]); v.z = pk_bf16(f[4], f[5]); v.w = pk_bf16(f[6], f[7]); return v; }

DI void phase_gla_norm(const Params& p, int g, int bid, int nb) {
  const GroupInfo gi = group_info(p, g);
  const bf16_t* of = (const bf16_t*)gi.out; const bf16_t* ob = of + (size_t)TOKG * 1024;
  const bf16_t* proj = (const bf16_t*)(p.ws + OFF_PROJ); bf16_t* dst = (bf16_t*)(p.ws + OFF_H);
  bf16_t* oa = (bf16_t*)(p.ws + OFF_OA); const bf16_t* oa2 = (const bf16_t*)(p.ws + OFF_OA2);
  const float lam = *(const float*)(p.ws + OFF_MISC + 1024);
  const int lane = TID() & 63, wave = TID() >> 6;
  float gn[16], sg[16];
#pragma unroll
  for (int e = 0; e < 16; ++e) { gn[e] = p.gla_norm_g[(lane & 15) * 16 + e]; sg[e] = p.subln_g[(lane & 7) * 16 + e] * 0.8f; }
  for (int tok = bid * 4 + wave; tok < TOKG; tok += nb * 4) {
    const size_t base = (size_t)tok * 1024 + lane * 16;
    const u32x4 f0 = *(const u32x4*)(of + base), f1 = *(const u32x4*)(of + base + 8), b0 = *(const u32x4*)(ob + base), b1 = *(const u32x4*)(ob + base + 8);
    const u32x4 g0 = *(const u32x4*)(proj + (size_t)tok * NPROJ + POG + lane * 16), g1 = *(const u32x4*)(proj + (size_t)tok * NPROJ + POG + lane * 16 + 8);
    const u32x4 a0 = *(const u32x4*)(oa + base), a1 = *(const u32x4*)(oa + base + 8), c0 = *(const u32x4*)(oa2 + base), c1 = *(const u32x4*)(oa2 + base + 8);
    float v[16], w[16], t[8], og[16];
    unpack8(f0, t);
#pragma unroll
    for (int e = 0; e < 8; ++e) v[e] = t[e];
    unpack8(f1, t);
#pragma unroll
    for (int e = 0; e < 8; ++e) v[8 + e] = t[e];
    unpack8(b0, t);
#pragma unroll
    for (int e = 0; e < 8; ++e) v[e] += t[e];
    unpack8(b1, t);
#pragma unroll
    for (int e = 0; e < 8; ++e) v[8 + e] += t[e];
    unpack8(g0, t);
#pragma unroll
    for (int e = 0; e < 8; ++e) og[e] = t[e];
    unpack8(g1, t);
#pragma unroll
    for (int e = 0; e < 8; ++e) og[8 + e] = t[e];
    if (gi.nseq == 1 && tok >= (128 - SPLIT_NS / 2) * 128) {
      const int x = lane >> 3, row = tok & 127, ai0 = (tok >> 7) * 2 - (256 - SPLIT_NS);
      const bf16_t* po = (const bf16_t*)(p.ws + OFF_PO); const float* pl = (const float*)(p.ws + OFF_PL);
#pragma unroll
      for (int m = 0; m < 2; ++m) {
        float acc[16], lsum = 0.f;
#pragma unroll
        for (int e = 0; e < 16; ++e) acc[e] = 0.f;
#pragma unroll
        for (int j = 0; j < SPLIT_SP; ++j) {
          const int sub = x * 64 + (ai0 + m) * SPLIT_SP + j;
          lsum += pl[sub * 128 + row];
          const bf16_t* src = po + (size_t)sub * 16384 + row * 128 + (lane & 7) * 16;
          unpack8(*(const u32x4*)src, t);
#pragma unroll
          for (int e = 0; e < 8; ++e) acc[e] += t[e];
          unpack8(*(const u32x4*)(src + 8), t);
#pragma unroll
          for (int e = 0; e < 8; ++e) acc[8 + e] += t[e];
        }
        const float sc = (m == 0) ? (1.f / lsum) : (-lam / lsum);
#pragma unroll
        for (int e = 0; e < 16; ++e) { if (m == 0) w[e] = acc[e] * sc; else w[e] += acc[e] * sc; }
      }
    } else {
      unpack8(a0, t);
#pragma unroll
      for (int e = 0; e < 8; ++e) w[e] = t[e];
      unpack8(a1, t);
#pragma unroll
      for (int e = 0; e < 8; ++e) w[8 + e] = t[e];
      unpack8(c0, t);
#pragma unroll
      for (int e = 0; e < 8; ++e) w[e] -= lam * t[e];
      unpack8(c1, t);
#pragma unroll
      for (int e = 0; e < 8; ++e) w[8 + e] -= lam * t[e];
    }
    float s1 = 0.f, s2 = 0.f;
#pragma unroll
    for (int e = 0; e < 16; ++e) { s1 += v[e] * v[e]; s2 += w[e] * w[e]; }
    s1 += __shfl_xor(s1, 1); s2 += __shfl_xor(s2, 1); s1 += __shfl_xor(s1, 2); s2 += __shfl_xor(s2, 2);
    s1 += __shfl_xor(s1, 4); s2 += __shfl_xor(s2, 4); s1 += __shfl_xor(s1, 8);
    const float r1 = rsqrtf(s1 * (1.f / 256.f) + EPSN), r2 = rsqrtf(s2 * (1.f / 128.f) + EPSN);
    float o1[8], o2[8];
#pragma unroll
    for (int e = 0; e < 8; ++e) { o1[e] = v[e] * r1 * gn[e] * og[e]; o2[e] = v[8 + e] * r1 * gn[8 + e] * og[8 + e]; }
    *(u32x4*)(dst + base) = pack8(o1); *(u32x4*)(dst + base + 8) = pack8(o2);
#pragma unroll
    for (int e = 0; e < 8; ++e) { o1[e] = w[e] * r2 * sg[e]; o2[e] = w[8 + e] * r2 * sg[8 + e]; }
    *(u32x4*)(oa + base) = pack8(o1); *(u32x4*)(oa + base + 8) = pack8(o2);
  }
}

DI void phase_merge(const Params& p, int g, char* smem, int bid, int nb) {
  bf16_t* As = (bf16_t*)smem; bf16_t* Bs = As + 128 * 72;
  const bf16_t* OA = (const bf16_t*)(p.ws + OFF_OA); const bf16_t* OB = (const bf16_t*)(p.ws + OFF_H);
  const bf16_t* WA = (const bf16_t*)(p.ws + OFF_WA); const bf16_t* WB = (const bf16_t*)(p.ws + OFF_WB);
  const bf16_t* proj = (const bf16_t*)(p.ws + OFF_PROJ); bf16_t* mg = (bf16_t*)(p.ws + OFF_GQ);
  const int lane = TID() & 63, wave = TID() >> 6, wm_ = wave >> 1, wn_ = wave & 1, h_ = lane >> 5, l31_ = lane & 31;
  TileSched ts(bid, nb, 8);
  int mt, nt;
  while (ts.next(mt, nt)) {
    f32x16 acc[2][2]; zero_acc(acc);
    gemm_tile<false>(OA + (size_t)mt * 128 * 1024, 1024, WA + (size_t)nt * 128 * 1024, 1024, 1024, acc, As, Bs);
    int wm = wm_, wn = wn_, h = h_, l31 = l31_; OPAQUE(wm); OPAQUE(wn); OPAQUE(h); OPAQUE(l31);
    const bf16_t* pt = proj + (size_t)mt * 128 * NPROJ; bf16_t* mgt = mg + (size_t)mt * 128 * 1024;
#pragma unroll
    for (int mi = 0; mi < 2; ++mi)
#pragma unroll
      for (int ni = 0; ni < 2; ++ni)
#pragma unroll
        for (int r = 0; r < 16; ++r) {
          const int off = (wm * 64 + mi * 32 + crow(r, h)) * NPROJ + nt * 128 + wn * 64 + ni * 32 + l31;
          const float sga = bf2f(pt[off + PGA]), sgb = fmaxf(bf2f(pt[off + PGB]), 1e-20f);
          acc[mi][ni][r] *= sga / sgb;
          if (r == 15) asm volatile("" ::: "memory");
        }
    gemm_tile<false>(OB + (size_t)mt * 128 * 1024, 1024, WB + (size_t)nt * 128 * 1024, 1024, 1024, acc, As, Bs);
    OPAQUE(wm); OPAQUE(wn); OPAQUE(h); OPAQUE(l31);
#pragma unroll
    for (int mi = 0; mi < 2; ++mi)
#pragma unroll
      for (int ni = 0; ni < 2; ++ni)
      {
        bf16_t gb16[16];
#pragma unroll
        for (int r = 0; r < 16; ++r) gb16[r] = pt[(wm * 64 + mi * 32 + crow(r, h)) * NPROJ + nt * 128 + wn * 64 + ni * 32 + l31 + PGB];
#pragma unroll
        for (int r = 0; r < 16; ++r) {
          const int rl = wm * 64 + mi * 32 + crow(r, h), cl = nt * 128 + wn * 64 + ni * 32 + l31;
          mgt[rl * 1024 + cl] = f2bf(acc[mi][ni][r] * fmaxf(bf2f(gb16[r]), 1e-20f));
        }
      }
  }
}

DI void phase_outproj(const Params& p, int g, char* smem, int bid, int nb) {
  const GroupInfo gi = group_info(p, g);
  bf16_t* As = (bf16_t*)smem; bf16_t* Bs = As + 128 * 72;
  const bf16_t* MG = (const bf16_t*)(p.ws + OFF_GQ); const bf16_t* WO = (const bf16_t*)(p.ws + OFF_WO);
  const float* mod = (const float*)(p.ws + OFF_MOD);
  const int lane = TID() & 63, wave = TID() >> 6, wm_ = wave >> 1, wn_ = wave & 1, h_ = lane >> 5, l31_ = lane & 31;
  TileSched ts(bid, nb, 8);
  int mt, nt;
  while (ts.next(mt, nt)) {
    f32x16 acc[2][2]; zero_acc(acc);
    gemm_tile<false>(MG + (size_t)mt * 128 * 1024, 1024, WO + (size_t)nt * 128 * 1024, 1024, 1024, acc, As, Bs);
    int wm = wm_, wn = wn_, h = h_, l31 = l31_; OPAQUE(wm); OPAQUE(wn); OPAQUE(h); OPAQUE(l31);
    const int b = row_batch(gi, mt * 128);
    const float* xt = gi.x + (size_t)mt * 128 * 1024; float* ot = gi.out + (size_t)mt * 128 * 1024;
#pragma unroll
    for (int ni = 0; ni < 2; ++ni) {
      const int col = nt * 128 + wn * 64 + ni * 32 + l31;
      const float gt = mod[b * 6144 + 2048 + col];
#pragma unroll
      for (int mi = 0; mi < 2; ++mi) {
        float xv[16];
#pragma unroll
        for (int r = 0; r < 16; ++r) xv[r] = xt[(wm * 64 + mi * 32 + crow(r, h)) * 1024 + col];
#pragma unroll
        for (int r = 0; r < 16; ++r) ot[(wm * 64 + mi * 32 + crow(r, h)) * 1024 + col] = xv[r] + gt * acc[mi][ni][r];

      }
    }
  }
}

DI void phase_up(const Params& p, int g, char* smem, int bid, int nb) {
  bf16_t* As = (bf16_t*)smem; bf16_t* Bs = As + 128 * 72;
  const bf16_t* H2 = (const bf16_t*)(p.ws + OFF_H); const bf16_t* WU = (const bf16_t*)(p.ws + OFF_WUP); bf16_t* U = (bf16_t*)(p.ws + OFF_PROJ);
  const int lane = TID() & 63, wave = TID() >> 6, wm_ = wave >> 1, wn_ = wave & 1, h_ = lane >> 5, l31_ = lane & 31;
  TileSched ts(bid, nb, 32);
  int mt, nt;
  while (ts.next(mt, nt)) {
    f32x16 acc[2][2]; zero_acc(acc);
    gemm_tile<false>(H2 + (size_t)mt * 128 * 1024, 1024, WU + (size_t)nt * 128 * 1024, 1024, 1024, acc, As, Bs);
    int wm = wm_, wn = wn_, h = h_, l31 = l31_; OPAQUE(wm); OPAQUE(wn); OPAQUE(h); OPAQUE(l31);
#pragma unroll
    for (int mi = 0; mi < 2; ++mi)
#pragma unroll
      for (int ni = 0; ni < 2; ++ni)
#pragma unroll
        for (int r = 0; r < 16; ++r) {
          const float v = fmaxf(acc[mi][ni][r], 0.f);
          (U + (size_t)mt * 128 * 4096)[(wm * 64 + mi * 32 + crow(r, h)) * 4096 + nt * 128 + wn * 64 + ni * 32 + l31] = f2bf(v * v);
        }
  }
}

DI void phase_down(const Params& p, int g, char* smem, int bid, int nb) {
  const GroupInfo gi = group_info(p, g);
  bf16_t* As = (bf16_t*)smem; bf16_t* Bs = As + 128 * 72;
  const bf16_t* U = (const bf16_t*)(p.ws + OFF_PROJ); const bf16_t* WD = (const bf16_t*)(p.ws + OFF_WDN);
  const float* mod = (const float*)(p.ws + OFF_MOD);
  const int lane = TID() & 63, wave = TID() >> 6, wm_ = wave >> 1, wn_ = wave & 1, h_ = lane >> 5, l31_ = lane & 31;
  TileSched ts(bid, nb, 8);
  int mt, nt;
  while (ts.next(mt, nt)) {
    f32x16 acc[2][2]; zero_acc(acc);
    gemm_tile<false>(U + (size_t)mt * 128 * 4096, 4096, WD + (size_t)nt * 128 * 4096, 4096, 4096, acc, As, Bs);
    int wm = wm_, wn = wn_, h = h_, l31 = l31_; OPAQUE(wm); OPAQUE(wn); OPAQUE(h); OPAQUE(l31);
    const int b = row_batch(gi, mt * 128);
    float* ot = gi.out + (size_t)mt * 128 * 1024;
#pragma unroll
    for (int ni = 0; ni < 2; ++ni) {
      const int col = nt * 128 + wn * 64 + ni * 32 + l31;
      const float gt = mod[b * 6144 + 5120 + col];
#pragma unroll
      for (int mi = 0; mi < 2; ++mi) {
        float xv[16];
#pragma unroll
        for (int r = 0; r < 16; ++r) xv[r] = ot[(wm * 64 + mi * 32 + crow(r, h)) * 1024 + col];
#pragma unroll
        for (int r = 0; r < 16; ++r) ot[(wm * 64 + mi * 32 + crow(r, h)) * 1024 + col] = xv[r] + gt * acc[mi][ni][r];

      }
    }
  }
}


#define XB_TMO      128
#define XB_XCNT(j)  (256  + 64 * (j))
#define XB_XSUB(j)  (1280 + 64 * (j))
#define XB_XGEN(j)  (2304 + 64 * (j))
#define XB_TOP      3328
#define XB_TOPGEN   3392
#define XCD_BAR_WORDS 3456
#define XB_SPIN_CAP (1u << 20)
#define LAS __attribute__((address_space(3)))
DI unsigned xb_ld(unsigned* p) { return __hip_atomic_load(p, __ATOMIC_RELAXED, __HIP_MEMORY_SCOPE_AGENT); }
DI unsigned xb_add(unsigned* p, unsigned v) { return __hip_atomic_fetch_add(p, v, __ATOMIC_RELAXED, __HIP_MEMORY_SCOPE_AGENT); }
DI unsigned xb_xcc_id() { return (unsigned)__builtin_amdgcn_s_getreg((3 << 11) | 20) & 0xFu; }
#define XB_SPIN(cond, bar) do { unsigned _sp = 0; while (cond) { __builtin_amdgcn_s_sleep(1); \
    if ((++_sp & 255u) == 0u) { if (xb_ld(&(bar)[XB_TMO])) break; if (_sp > XB_SPIN_CAP) { atomicAdd(&(bar)[XB_TMO], 1u); break; } } } } while (0)
struct XcdBarrier { unsigned* bar; unsigned x; volatile LAS unsigned* st; };
DI XcdBarrier xcd_barrier_post(unsigned* bar, volatile LAS unsigned* st) {
  XcdBarrier b; b.bar = bar; b.x = xb_xcc_id(); b.st = st;
  if (threadIdx.x == 0) (void)xb_add(&bar[XB_XCNT(b.x)], 1u);
  return b;
}
DI void xcd_barrier_complete(unsigned* bar, unsigned x, unsigned& nloc, unsigned& nx) {
  const unsigned G = gridDim.x * gridDim.y * gridDim.z;
  unsigned sum, cnt, mine, sp = 0u;
  for (;;) {
    sum = 0u; cnt = 0u; mine = 0u;
#pragma unroll
    for (unsigned j = 0; j < 16; ++j) { const unsigned c = xb_ld(&bar[XB_XCNT(j)]); sum += c; cnt += (c > 0u) ? 1u : 0u; mine = (j == x) ? c : mine; }
    if (sum == G) break;
    __builtin_amdgcn_s_sleep(1);
    if ((++sp & 255u) == 0u) { if (xb_ld(&bar[XB_TMO])) break; if (sp > XB_SPIN_CAP) { atomicAdd(&bar[XB_TMO], 1u); break; } }
  }
  nloc = mine > 0u ? mine : 1u; nx = cnt > 0u ? cnt : 1u;
}
DI void xcd_barrier(const XcdBarrier& b) {
  asm volatile("s_waitcnt vmcnt(0)" ::: "memory");
  __syncthreads();
  if (threadIdx.x == 0) {
    unsigned* bar = b.bar;
    __builtin_amdgcn_s_waitcnt(0);
    unsigned nloc = b.st[0], nx = b.st[1];
    if (nloc == 0u) { xcd_barrier_complete(bar, b.x, nloc, nx); b.st[0] = nloc; b.st[1] = nx; }
    const unsigned old = xb_add(&bar[XB_XSUB(b.x)], 1u);
    const unsigned gen = old / nloc;
    if (old + 1u == (gen + 1u) * nloc) {
      __builtin_amdgcn_fence(__ATOMIC_RELEASE, "agent");
      asm volatile("s_waitcnt vmcnt(0)" ::: "memory");
      const unsigned og = xb_add(&bar[XB_TOP], 1u);
      const unsigned tg = og / nx;
      if (og + 1u == (tg + 1u) * nx) xb_add(&bar[XB_TOPGEN], 1u);
      else XB_SPIN(xb_ld(&bar[XB_TOPGEN]) == tg, bar);
      __builtin_amdgcn_fence(__ATOMIC_ACQUIRE, "agent");
      xb_add(&bar[XB_XGEN(b.x)], 1u);
      asm volatile("s_waitcnt vmcnt(0)" ::: "memory");
    } else {
      XB_SPIN(xb_ld(&bar[XB_XGEN(b.x)]) == gen, bar);
      __builtin_amdgcn_fence(__ATOMIC_ACQUIRE, "agent");
      asm volatile("s_waitcnt vmcnt(0)" ::: "memory");
    }
  }
  __syncthreads();
}

constexpr int SMEM_BYTES = 4 * 128 * 72 * 2;

DI void run_phase(const Params& p, int ph, int g, char* smem, int* s_item, int bid, int nb) {
  switch (ph) {
    case 0: phase_prologue(p, smem, bid, nb); break;
    case 1: { const GroupInfo gi = group_info(p, g); phase_modnorm(p, g, gi.x, p.norm1_g, 0, 1024, bid, nb); } break;
    case 2: phase_gemm1(p, g, smem, bid, nb); break;
    case 3: phase_gla_prep(p, g, smem, bid, nb); break;
    case 4: phase_mixers(p, g, smem, s_item, bid); break;
    case 5: phase_gla_norm(p, g, bid, nb); break;
    case 6: phase_merge(p, g, smem, bid, nb); break;
    case 7: phase_outproj(p, g, smem, bid, nb); break;
    case 8: { const GroupInfo gi = group_info(p, g); phase_modnorm(p, g, gi.out, p.norm2_g, 3072, 4096, bid, nb); } break;
    case 9: phase_up(p, g, smem, bid, nb); break;
    case 10: phase_down(p, g, smem, bid, nb); break;
    default: break;
  }
}

template <int PH>
__global__ void __launch_bounds__(256, 2) k_phase(Params p, int g) {
  extern __shared__ __attribute__((aligned(16))) char smem[];
  __shared__ int s_item;
  run_phase(p, PH, g, smem, &s_item, blockIdx.x, gridDim.x);
}
template <int PH> static void launch_phase(const Params& p, int g, hipStream_t stream) { (void)hipFuncSetAttribute((const void*)k_phase<PH>, hipFuncAttributeMaxDynamicSharedMemorySize, SMEM_BYTES); k_phase<PH><<<512, 256, SMEM_BYTES, stream>>>(p, g); }

#if ONE_LAUNCH
__global__ void __launch_bounds__(256, 2) k_mega(Params p) {
  extern __shared__ __attribute__((aligned(16))) char smem[];
  __shared__ int s_item;
  __shared__ uint4 xb_words;
  cg::grid_group grid = cg::this_grid();
  const int bid = blockIdx.x, nb = gridDim.x;
  if (threadIdx.x == 0) xb_words = make_uint4(0u, 0u, 0u, 0u);
  __syncthreads();
  (void)xcd_barrier_post((unsigned*)(p.ws + OFF_BAR), (volatile LAS unsigned*)&xb_words);
  auto seam = [&]() __attribute__((always_inline)) {
    XcdBarrier b; b.bar = (unsigned*)(p.ws + OFF_BAR); b.x = xb_xcc_id(); b.st = (volatile LAS unsigned*)&xb_words;
    xcd_barrier(b);
  };
  run_phase(p, 0, 0, smem, &s_item, bid, nb);
  if (p.ws == nullptr) grid.sync();
  seam();
#pragma unroll 1
  for (int g = 0; g < 3; ++g) {
#pragma unroll 1
    for (int ph = (g == 0 ? 1 : 2); ph <= 10; ++ph) {
      run_phase(p, ph, g, smem, &s_item, bid, nb);
      if (ph == p.probe_mode) { seam(); run_phase(p, ph, g, smem, &s_item, bid, nb); }
      if (ph == 10 && g < 2) run_phase(p, 1, g + 1, smem, &s_item, bid, nb);
      if (!(g == 2 && ph == 10)) seam();
    }
  }
}
#endif

extern "C" void kernel_launch(void* const* d_in, const int* in_sizes, int n_in, void* d_out, int out_size, void* d_ws, size_t ws_size, hipStream_t stream) {
  Params p{};
  const float** pp = (const float**)&p;
  for (int i = 0; i < 27; ++i) pp[i] = (const float*)d_in[i];
  p.out = (float*)d_out;
  p.ws = (char*)d_ws;
  p.probe_mode = PROBE_MODE; p.pad_ = 0;
  if (ws_size < WS_TOTAL) { fprintf(stderr, "workspace too small: %zu < %zu\n", ws_size, (size_t)WS_TOTAL); return; }
#if ONE_LAUNCH
  static int grid_blocks = 0;
  if (!grid_blocks) {
    int dev = 0, cus = 0, per_cu = 0;
    hipGetDevice(&dev);
    hipDeviceGetAttribute(&cus, hipDeviceAttributeMultiprocessorCount, dev);
    (void)hipFuncSetAttribute((const void*)k_mega, hipFuncAttributeMaxDynamicSharedMemorySize, SMEM_BYTES);
    hipOccupancyMaxActiveBlocksPerMultiprocessor(&per_cu, k_mega, 256, SMEM_BYTES);
    if (per_cu > 2) per_cu = 2;
    grid_blocks = cus * per_cu;
  }
  hipMemsetAsync((char*)d_ws + OFF_MISC, 0, 32768, stream);
  void* args[] = {&p};
  hipError_t e = hipLaunchCooperativeKernel((void*)k_mega, dim3(grid_blocks), dim3(256), args, SMEM_BYTES, stream);
  if (e != hipSuccess) fprintf(stderr, "cooperative launch failed: %s (grid %d)\n", hipGetErrorString(e), grid_blocks);
#else
  hipMemsetAsync((char*)d_ws + OFF_MISC, 0, 32768, stream);
  launch_phase<0>(p, 0, stream);
  for (int g = 0; g < 3; ++g) {
    launch_phase<1>(p, g, stream); launch_phase<2>(p, g, stream); launch_phase<3>(p, g, stream); launch_phase<4>(p, g, stream); launch_phase<5>(p, g, stream);
    launch_phase<6>(p, g, stream); launch_phase<7>(p, g, stream); launch_phase<8>(p, g, stream); launch_phase<9>(p, g, stream); launch_phase<10>(p, g, stream);
  }
#endif
}
```

```cpp
#include <hip/hip_runtime.h>
#include <hip/hip_cooperative_groups.h>
#include <cstdint>
#include <cstdio>
namespace cg = cooperative_groups;

#define PROBE_MODE 0
#ifndef ONE_LAUNCH
#define ONE_LAUNCH 1
#endif

#define DI __device__ __forceinline__
typedef unsigned short bf16_t;
typedef short bf16x8 __attribute__((ext_vector_type(8)));
typedef float f32x16 __attribute__((ext_vector_type(16)));
typedef float f32x4 __attribute__((ext_vector_type(4)));
typedef float f32x2 __attribute__((ext_vector_type(2)));
typedef unsigned u32x4 __attribute__((ext_vector_type(4)));
typedef unsigned u32x2 __attribute__((ext_vector_type(2)));
typedef __bf16 bf16v2 __attribute__((ext_vector_type(2)));
#define OPAQUE(x) asm volatile("" : "+v"(x))
__device__ __forceinline__ int TID() { int t = threadIdx.x; asm volatile("" : "+v"(t)); return t; }
#define MFMA32(a, b, c) __builtin_amdgcn_mfma_f32_32x32x16_bf16((a), (b), (c), 0, 0, 0)

constexpr int TOKG = 16384;
constexpr int NPROJ = 5120;
constexpr int PQG = 1024, PKG = 1536, POG = 2048, PGA = 3072, PGB = 4096;
constexpr float EPSN = 1e-6f;
constexpr float LOG2E = 1.4426950408889634f;
constexpr float QSCALE = 0.125f * LOG2E;

constexpr size_t MiB = 1024 * 1024;
constexpr size_t OFF_WIN = 0;
constexpr size_t OFF_WA = OFF_WIN + (size_t)8320 * 1024 * 2;
constexpr size_t OFF_WB = OFF_WA + 2 * MiB;
constexpr size_t OFF_WO = OFF_WB + 2 * MiB;
constexpr size_t OFF_WUP = OFF_WO + 2 * MiB;
constexpr size_t OFF_WDN = OFF_WUP + 8 * MiB;
constexpr size_t OFF_MOD = OFF_WDN + 8 * MiB;
constexpr size_t OFF_MISC = OFF_MOD + 512 * 1024;
constexpr size_t OFF_BAR = OFF_MISC + 4096;
constexpr size_t OFF_H = OFF_MISC + 32768;
constexpr size_t OFF_PROJ = OFF_H + 32 * MiB;
constexpr size_t OFF_KBLK = OFF_PROJ + 160 * MiB;
constexpr size_t OFF_VAT = OFF_KBLK + 32 * MiB;
constexpr size_t OFF_VGT = OFF_VAT + 32 * MiB;
constexpr size_t OFF_LR = OFF_VGT + 32 * MiB;
constexpr size_t OFF_GQ = OFF_LR + 2 * MiB;
constexpr size_t OFF_GK = OFF_GQ + 32 * MiB;
constexpr size_t OFF_GKT = OFF_GK + 32 * MiB;
constexpr size_t OFF_GE = OFF_GKT + 32 * MiB;
constexpr size_t OFF_OA = OFF_GE + 1 * MiB;
constexpr size_t OFF_OA2 = OFF_OA + 32 * MiB;
constexpr size_t OFF_PO = OFF_OA2 + 32 * MiB;
constexpr size_t OFF_PL = OFF_PO + 16 * MiB;
constexpr size_t WS_TOTAL = OFF_PL + 256 * 1024;
constexpr int SPLIT_NS = 16, SPLIT_SP = 4;

struct Params {
  const float *x_prompt, *x_sample, *c_prompt, *c_sample, *rel_bias, *w_ada, *b_ada, *norm1_g, *w_in, *q_norm_g, *k_norm_g,
      *lam_q1, *lam_k1, *lam_q2, *lam_k2, *subln_g, *w_gate_f, *b_gate_f, *w_gate_b, *b_gate_b, *gla_norm_g, *w_branch_a,
      *w_branch_b, *w_out, *norm2_g, *w_up, *w_down;
  float* out;
  char* ws;
  int probe_mode; int pad_;
};

DI void lds_barrier() { asm volatile("s_waitcnt lgkmcnt(0)\n\ts_barrier" ::: "memory"); }
DI float bf2f(bf16_t v) { return __uint_as_float(((unsigned)v) << 16); }
DI unsigned pk_bf16(float lo, float hi) { f32x2 v = {lo, hi}; bf16v2 b = __builtin_convertvector(v, bf16v2); return __builtin_bit_cast(unsigned, b); }
DI bf16_t f2bf(float x) { return (bf16_t)(pk_bf16(x, 0.f) & 0xffffu); }
DI int crow(int r, int h) { return (r & 3) + 8 * (r >> 2) + 4 * h; }
DI float sigmoidf_(float x) { return 1.f / (1.f + __expf(-x)); }
DI int permpos(int t) { return (t & ~12) | ((t & 4) << 1) | ((t & 8) >> 1); }
DI float half_sum32(float v) {
  v += __shfl_xor(v, 1); v += __shfl_xor(v, 2); v += __shfl_xor(v, 4); v += __shfl_xor(v, 8); v += __shfl_xor(v, 16); return v;
}
DI void zero_acc(f32x16 (&acc)[2][2]) {
#pragma unroll
  for (int a = 0; a < 2; ++a)
#pragma unroll
    for (int b = 0; b < 2; ++b)
#pragma unroll
      for (int r = 0; r < 16; ++r) acc[a][b][r] = 0.f;
}

struct GroupInfo { int S, nseq, b0; const float* x; float* out; };
DI GroupInfo group_info(const Params& p, int g) {
  GroupInfo gi;
  if (g == 0) { gi.S = 16384; gi.nseq = 1; gi.b0 = 0; gi.x = p.x_prompt; }
  else { gi.S = 2048; gi.nseq = 8; gi.b0 = 1 + (g - 1) * 8; gi.x = p.x_sample + (size_t)(g - 1) * TOKG * 1024; }
  gi.out = p.out + (size_t)g * TOKG * 1024;
  return gi;
}
DI int row_batch(const GroupInfo& gi, int row) { return gi.b0 + (gi.nseq == 1 ? 0 : (row >> 11)); }

constexpr int GT_IMG = 128 * 72;
template <bool SWAP>
DI void gemm_tile(const bf16_t* __restrict__ A, int lda, const bf16_t* __restrict__ Bt, int ldb, int K, f32x16 (&acc)[2][2], bf16_t* As, bf16_t* Bs_unused) {
  (void)Bs_unused;
  const int tid = TID(), lane = tid & 63, wave = tid >> 6, wm = wave >> 1, wn = wave & 1;
  const int lr = tid >> 3, lc = (tid & 7) * 8;
  const bf16_t* ga = A + (size_t)lr * lda + lc;
  const bf16_t* gb = Bt + (size_t)lr * ldb + lc;
  u32x4 ra0[4], rb0[4], ra1[4], rb1[4];
  auto load_stage = [&](u32x4 (&ra)[4], u32x4 (&rb)[4], int t) __attribute__((always_inline)) {
#pragma unroll
    for (int i = 0; i < 4; ++i) { ra[i] = *(const u32x4*)(ga + (size_t)(32 * i) * lda + t * 64); rb[i] = *(const u32x4*)(gb + (size_t)(32 * i) * ldb + t * 64); }
  };
  auto write_stage = [&](const u32x4 (&ra)[4], const u32x4 (&rb)[4], int buf) __attribute__((always_inline)) {
    bf16_t* Ad = As + buf * 2 * GT_IMG; bf16_t* Bd = Ad + GT_IMG;
#pragma unroll
    for (int i = 0; i < 4; ++i) { *(u32x4*)(Ad + (lr + 32 * i) * 72 + lc) = ra[i]; *(u32x4*)(Bd + (lr + 32 * i) * 72 + lc) = rb[i]; }
  };
  const int fr = lane & 31, fk = (lane >> 5) * 8;
  const int pao = (wm * 64 + fr) * 72 + fk, pbo = GT_IMG + (wn * 64 + fr) * 72 + fk;
  auto frag_read = [&](bf16x8 (&f)[4], const bf16_t* pa, const bf16_t* pb, int so) __attribute__((always_inline)) {
    f[0] = *(const bf16x8*)(pa + so); f[1] = *(const bf16x8*)(pb + so); f[2] = *(const bf16x8*)(pb + 32 * 72 + so); f[3] = *(const bf16x8*)(pa + 32 * 72 + so);
  };
  auto mfma4 = [&](const bf16x8 (&f)[4]) __attribute__((always_inline)) {
    if (SWAP) {
      acc[0][0] = MFMA32(f[1], f[0], acc[0][0]); acc[0][1] = MFMA32(f[2], f[0], acc[0][1]);
      acc[1][0] = MFMA32(f[1], f[3], acc[1][0]); acc[1][1] = MFMA32(f[2], f[3], acc[1][1]);
    } else {
      acc[0][0] = MFMA32(f[0], f[1], acc[0][0]); acc[0][1] = MFMA32(f[0], f[2], acc[0][1]);
      acc[1][0] = MFMA32(f[3], f[1], acc[1][0]); acc[1][1] = MFMA32(f[3], f[2], acc[1][1]);
    }
  };
  auto step = [&](int buf, u32x4 (&ra)[4], u32x4 (&rb)[4], bool do_write, bool do_load, int tload) __attribute__((always_inline)) {
    const bf16_t* pa = As + buf * 2 * GT_IMG + pao; const bf16_t* pb = As + buf * 2 * GT_IMG + pbo;
    bf16_t* Ad = As + (buf ^ 1) * 2 * GT_IMG; bf16_t* Bd = Ad + GT_IMG;
    bf16x8 F0[4], F1[4];
    frag_read(F0, pa, pb, 0);
    __builtin_amdgcn_sched_barrier(0);
    frag_read(F1, pa, pb, 16);
    mfma4(F0);
    __builtin_amdgcn_sched_barrier(0);
    frag_read(F0, pa, pb, 32);
    mfma4(F1);
    if (do_write) {
#pragma unroll
      for (int i = 0; i < 4; ++i) *(u32x4*)(Ad + (lr + 32 * i) * 72 + lc) = ra[i];
    }
    __builtin_amdgcn_sched_barrier(0);
    frag_read(F1, pa, pb, 48);
    mfma4(F0);
    if (do_write) {
#pragma unroll
      for (int i = 0; i < 4; ++i) *(u32x4*)(Bd + (lr + 32 * i) * 72 + lc) = rb[i];
    }
    __builtin_amdgcn_sched_barrier(0);
    mfma4(F1);
    if (do_load) load_stage(ra, rb, tload);
    __builtin_amdgcn_sched_barrier(0);
  };
  const int nk = K >> 6;
  load_stage(ra0, rb0, 0); load_stage(ra1, rb1, 1);
  __syncthreads();
  write_stage(ra0, rb0, 0);
  load_stage(ra0, rb0, 2);
  __syncthreads();
  for (int kt = 0; kt < nk; kt += 2) {
    step(0, ra1, rb1, true, kt + 3 < nk, kt + 3);
    __syncthreads();
    step(1, ra0, rb0, kt + 2 < nk, kt + 4 < nk, kt + 4);
    __syncthreads();
  }
}

struct TileSched {
  int j, step, total, NT, xcd, simple;
  DI TileSched(int bid, int nb, int NT_) {
    NT = NT_;
    if ((nb & 7) == 0) { xcd = bid & 7; j = bid >> 3; step = nb >> 3; total = 16 * NT; simple = 0; }
    else { xcd = 0; j = bid; step = nb; total = 128 * NT; simple = 1; }
  }
  DI bool next(int& mt, int& nt) {
    if (j >= total) return false;
    if (simple) { mt = j & 127; nt = j >> 7; }
    else { const int half = j / (8 * NT), jj = j - half * 8 * NT; mt = xcd * 16 + half * 8 + (jj & 7); nt = jj >> 3; }
    j += step; return true;
  }
};

DI int win_src_col(int n) { return n < 6144 ? n : (n < 8192 ? n + 32 : (n < 8224 ? n - 2048 : -1)); }

DI void transpose_tile(const float* __restrict__ W, int ldw, bf16_t* __restrict__ Wt, int K, int kt, int nt, bool is_win, float* sm) {
  const int tid = TID(), c = tid & 63, r0 = tid >> 6;
  const int n = nt * 64 + c; const int src = is_win ? win_src_col(n) : n;
  __syncthreads();
#pragma unroll
  for (int i = 0; i < 16; ++i) { const int k = r0 + 4 * i; sm[k * 65 + c] = (src >= 0) ? W[(size_t)(kt * 64 + k) * ldw + src] : 0.f; }
  __syncthreads();
#pragma unroll
  for (int i = 0; i < 16; ++i) { const int nn = r0 + 4 * i; Wt[(size_t)(nt * 64 + nn) * K + kt * 64 + c] = f2bf(sm[c * 65 + nn]); }
}

DI void mod_item(const Params& p, int cgi, char* smem) {
  float* tab = (float*)smem;
  float* red = tab + 17 * 512;
  float* mod = (float*)(p.ws + OFF_MOD);
  const int tid = TID(), cl = tid & 63, kq = tid >> 6, col = cgi * 64 + cl;
  float acc[17];
#pragma unroll
  for (int b = 0; b < 17; ++b) acc[b] = 0.f;
  for (int pass = 0; pass < 2; ++pass) {
    __syncthreads();
    for (int i = tid; i < 17 * 512; i += 256) {
      const int b = i >> 9, k = pass * 512 + (i & 511);
      const float cv = (b == 0) ? p.c_prompt[k] : p.c_sample[(b - 1) * 1024 + k];
      tab[i] = cv / (1.f + __expf(-cv));
    }
    __syncthreads();
    for (int kk = 0; kk < 128; kk += 16) {
      float w[16];
#pragma unroll
      for (int u = 0; u < 16; ++u) w[u] = p.w_ada[(size_t)(pass * 512 + kq * 128 + kk + u) * 6144 + col];
#pragma unroll
      for (int u = 0; u < 16; ++u) {
        const int k = kq * 128 + kk + u;
#pragma unroll
        for (int b = 0; b < 17; ++b) acc[b] += tab[b * 512 + k] * w[u];
      }
    }
  }
  __syncthreads();
#pragma unroll
  for (int b = 0; b < 17; ++b) red[(kq * 17 + b) * 64 + cl] = acc[b];
  __syncthreads();
  for (int i = tid; i < 17 * 64; i += 256) {
    const int b = i >> 6, c = i & 63;
    const float s = red[(0 * 17 + b) * 64 + c] + red[(1 * 17 + b) * 64 + c] + red[(2 * 17 + b) * 64 + c] + red[(3 * 17 + b) * 64 + c];
    mod[b * 6144 + cgi * 64 + c] = s + p.b_ada[cgi * 64 + c];
  }
}

DI void phase_prologue(const Params& p, char* smem, int bid, int nb) {
  constexpr int N0 = 96, N1 = N0 + 2080, N2 = N1 + 256, N3 = N2 + 256, N4 = N3 + 256, N5 = N4 + 1024, N6 = N5 + 1024;
  for (int it = bid; it < N6 + 1; it += nb) {
    if (it < N0) mod_item(p, it, smem);
    else if (it < N1) { const int t = it - N0; transpose_tile(p.w_in, 8224, (bf16_t*)(p.ws + OFF_WIN), 1024, t & 15, t >> 4, true, (float*)smem); }
    else if (it < N2) { const int t = it - N1; transpose_tile(p.w_branch_a, 1024, (bf16_t*)(p.ws + OFF_WA), 1024, t & 15, t >> 4, false, (float*)smem); }
    else if (it < N3) { const int t = it - N2; transpose_tile(p.w_branch_b, 1024, (bf16_t*)(p.ws + OFF_WB), 1024, t & 15, t >> 4, false, (float*)smem); }
    else if (it < N4) { const int t = it - N3; transpose_tile(p.w_out, 1024, (bf16_t*)(p.ws + OFF_WO), 1024, t & 15, t >> 4, false, (float*)smem); }
    else if (it < N5) { const int t = it - N4; transpose_tile(p.w_up, 4096, (bf16_t*)(p.ws + OFF_WUP), 1024, t & 15, t >> 4, false, (float*)smem); }
    else if (it < N6) { const int t = it - N5; transpose_tile(p.w_down, 1024, (bf16_t*)(p.ws + OFF_WDN), 4096, t & 63, t >> 6, false, (float*)smem); }
    else {
      int* ctr = (int*)(p.ws + OFF_MISC);
      if (TID() < 64) ctr[TID()] = 0;
      if (TID() >= 64 && TID() < 128) {
        const int l = TID() - 64;
        float a = p.lam_q1[l] * p.lam_k1[l], b = p.lam_q2[l] * p.lam_k2[l];
#pragma unroll
        for (int m = 32; m >= 1; m >>= 1) { a += __shfl_xor(a, m); b += __shfl_xor(b, m); }
        if (l == 0) *(float*)(p.ws + OFF_MISC + 1024) = __expf(a) - __expf(b) + 0.2f;
      }
    }
  }
}

DI void phase_modnorm(const Params& p, int g, const float* xin, const float* gvec, int shift_off, int scale_off, int bid, int nb) {
  const GroupInfo gi = group_info(p, g);
  const float* mod = (const float*)(p.ws + OFF_MOD);
  bf16_t* hout = (bf16_t*)(p.ws + OFF_H);
  const int lane = TID() & 63, wave = TID() >> 6;
  for (int row = bid * 4 + wave; row < TOKG; row += nb * 4) {
    const int b = row_batch(gi, row);
    const float* xr = xin + (size_t)row * 1024;
    f32x4 v[4]; float ss = 0.f;
#pragma unroll
    for (int i = 0; i < 4; ++i) { v[i] = *(const f32x4*)(xr + i * 256 + lane * 4); ss += v[i][0] * v[i][0] + v[i][1] * v[i][1] + v[i][2] * v[i][2] + v[i][3] * v[i][3]; }
#pragma unroll
    for (int m = 32; m >= 1; m >>= 1) ss += __shfl_xor(ss, m);
    const float rs = rsqrtf(ss * (1.f / 1024.f) + EPSN);
#pragma unroll
    for (int i = 0; i < 4; ++i) {
      const int c = i * 256 + lane * 4;
      const f32x4 gv = *(const f32x4*)(gvec + c), sc = *(const f32x4*)(mod + b * 6144 + scale_off + c), sh = *(const f32x4*)(mod + b * 6144 + shift_off + c);
      f32x4 y;
#pragma unroll
      for (int e = 0; e < 4; ++e) y[e] = v[i][e] * rs * gv[e] * (1.f + sc[e]) + sh[e];
      u32x2 o; o.x = pk_bf16(y[0], y[1]); o.y = pk_bf16(y[2], y[3]);
      *(u32x2*)(hout + (size_t)row * 1024 + c) = o;
    }
  }
}

DI void phase_gemm1(const Params& p, int g, char* smem, int bid, int nb) {
  bf16_t* As = (bf16_t*)smem; bf16_t* Bs = As + 128 * 72;
  const bf16_t* H = (const bf16_t*)(p.ws + OFF_H); const bf16_t* W = (const bf16_t*)(p.ws + OFF_WIN);
  bf16_t* proj = (bf16_t*)(p.ws + OFF_PROJ); bf16_t* vaT = (bf16_t*)(p.ws + OFF_VAT); bf16_t* vgT = (bf16_t*)(p.ws + OFF_VGT); bf16_t* kblk = (bf16_t*)(p.ws + OFF_KBLK);
  float* lrb = (float*)(p.ws + OFF_LR);
  const int lane = TID() & 63, wave = TID() >> 6, wm_ = wave >> 1, wn_ = wave & 1, h_ = lane >> 5, l31_ = lane & 31;
  TileSched ts(bid, nb, 65);
  int mt, nt;
  while (ts.next(mt, nt)) {
    f32x16 acc[2][2]; zero_acc(acc);
    const bool swp = (nt >= 16 && nt < 24) || (nt >= 32 && nt < 40);
    const bf16_t* A = H + (size_t)mt * 128 * 1024; const bf16_t* B = W + (size_t)nt * 128 * 1024;
    if (swp) gemm_tile<true>(A, 1024, B, 1024, 1024, acc, As, Bs); else gemm_tile<false>(A, 1024, B, 1024, 1024, acc, As, Bs);
    int wm = wm_, wn = wn_, h = h_, l31 = l31_; OPAQUE(wm); OPAQUE(wn); OPAQUE(h); OPAQUE(l31);
    const int row0 = mt * 128;
    bf16_t* projt = proj + (size_t)row0 * NPROJ;
    if (nt < 16) {
      const float* gn = (nt < 8) ? p.q_norm_g : p.k_norm_g; const float sc = (nt < 8) ? QSCALE : 1.f;
      const float g0 = gn[l31] * sc, g1 = gn[32 + l31] * sc;
#pragma unroll
      for (int mi = 0; mi < 2; ++mi) {
        bf16_t* kt = kblk + ((size_t)((nt - 8) * 2 + wn) * 512 + ((row0 + wm * 64 + mi * 32) >> 5)) * 2048 + l31;
#pragma unroll
        for (int r = 0; r < 16; ++r) {
          const float a0 = acc[mi][0][r], a1 = acc[mi][1][r];
          const float ss = half_sum32(a0 * a0 + a1 * a1);
          const float rs = rsqrtf(ss * (1.f / 64.f) + EPSN);
          bf16_t* dst = (nt < 8) ? (projt + (wm * 64 + mi * 32 + crow(r, h)) * NPROJ + nt * 128 + wn * 64 + l31) : (kt + crow(r, h) * 64);
          dst[0] = f2bf(a0 * rs * g0); dst[32] = f2bf(a1 * rs * g1);
        }
      }
    } else if (nt < 24) {
#pragma unroll
      for (int mi = 0; mi < 2; ++mi) {
        const int tok = row0 + wm * 64 + mi * 32 + l31, pp = permpos(tok) & 31, tile = tok >> 5;
#pragma unroll
        for (int ni = 0; ni < 2; ++ni)
#pragma unroll
          for (int r = 0; r < 16; ++r) {
            const int n = (nt - 16) * 128 + wn * 64 + ni * 32 + crow(r, h); const int hd = n >> 7, dv = n & 127;
            vaT[((size_t)(hd * 512 + tile) * 128 + dv) * 32 + pp] = f2bf(acc[mi][ni][r]);
          }
      }
    } else if (nt < 40 && nt >= 32) {
#pragma unroll
      for (int mi = 0; mi < 2; ++mi) {
        const int tok = row0 + wm * 64 + mi * 32 + l31, chunk = tok >> 6, tk = tok & 63;
#pragma unroll
        for (int ni = 0; ni < 2; ++ni)
#pragma unroll
          for (int r = 0; r < 16; ++r) {
            const int n = (nt - 32) * 128 + wn * 64 + ni * 32 + crow(r, h); const int hd = n >> 8, dv = n & 255;
            vgT[((size_t)(hd * 256 + chunk) * 256 + dv) * 64 + tk] = f2bf(acc[mi][ni][r]);
          }
      }
    } else if (nt < 64) {
      const int coff = (nt < 32) ? nt * 128 - 2048 : nt * 128 - 3072;
      const int mode = (nt < 32) ? 0 : (nt < 48 ? 1 : 2);
#pragma unroll
      for (int mi = 0; mi < 2; ++mi)
#pragma unroll
        for (int ni = 0; ni < 2; ++ni)
#pragma unroll
          for (int r = 0; r < 16; ++r) {
            float v = acc[mi][ni][r];
            if (mode == 1) v = v * sigmoidf_(v); else if (mode == 2) v = sigmoidf_(v);
            projt[(wm * 64 + mi * 32 + crow(r, h)) * NPROJ + coff + wn * 64 + ni * 32 + l31] = f2bf(v);
          }
    } else {
      if (wn == 0) {
#pragma unroll
        for (int mi = 0; mi < 2; ++mi)
#pragma unroll
          for (int r = 0; r < 16; ++r) (lrb + (size_t)row0 * 32)[(wm * 64 + mi * 32 + crow(r, h)) * 32 + l31] = acc[mi][0][r];
      }
    }
  }
}

DI float logsig16(float z) { return (fminf(z, 0.f) - __logf(1.f + __expf(-fabsf(z)))) * (1.f / 16.f); }

DI void phase_gla_prep(const Params& p, int g, char* smem, int bid, int nb) {
  float* lrs = (float*)smem;
  float* tot = lrs + 1024;
  const bf16_t* proj = (const bf16_t*)(p.ws + OFF_PROJ); const float* lrb = (const float*)(p.ws + OFF_LR);
  bf16_t* gq = (bf16_t*)(p.ws + OFF_GQ); bf16_t* gk = (bf16_t*)(p.ws + OFF_GK); bf16_t* gkt = (bf16_t*)(p.ws + OFF_GKT); float* ge = (float*)(p.ws + OFF_GE);
  const int tid = TID(), d = tid & 127, half = tid >> 7;
  for (int item = bid; item < 2048; item += nb) {
    const int c = item & 255, head = (item >> 8) & 3, dir = item >> 10, dd = head * 128 + d;
    __syncthreads();
#pragma unroll
    for (int i = 0; i < 4; ++i) { const int idx = tid + 256 * i; lrs[idx] = lrb[(size_t)(c * 64 + (idx >> 4)) * 32 + dir * 16 + (idx & 15)]; }
    const float* wgp = dir ? p.w_gate_b : p.w_gate_f;
    float wg[16];
#pragma unroll
    for (int r = 0; r < 16; ++r) wg[r] = wgp[r * 512 + dd];
    const float bg = (dir ? p.b_gate_b : p.b_gate_f)[dd];
    __syncthreads();
    float tsum = 0.f;
    for (int tt = 0; tt < 32; ++tt) {
      const float* l = lrs + (half * 32 + tt) * 16; float z = bg;
#pragma unroll
      for (int r = 0; r < 16; ++r) z += l[r] * wg[r];
      tsum += logsig16(z);
    }
    tot[half * 128 + d] = tsum;
    __syncthreads();
    const float t0 = tot[d], t1 = tot[128 + d], TOTAL = t0 + t1;
    float run = half ? t0 : 0.f;
    const size_t blk = (size_t)((dir * 4 + head) * 256 + c);
    unsigned ktp[16];
#pragma unroll
    for (int tt = 0; tt < 32; ++tt) {
      const int t = half * 32 + tt;
      const float* l = lrs + t * 16; float z = bg;
#pragma unroll
      for (int r = 0; r < 16; ++r) z += l[r] * wg[r];
      const float gv = logsig16(z);
      const float b = dir ? (TOTAL - run) : (run + gv);
      run += gv;
      const size_t tg = (size_t)c * 64 + t;
      const float qv = bf2f(proj[tg * NPROJ + PQG + dd]), kv = bf2f(proj[tg * NPROJ + PKG + dd]);
      const float qt = qv * __expf(b) * 0.08838834764831845f, kt = kv * __expf(-b);
      gq[(blk * 64 + t) * 128 + d] = f2bf(qt);
      const bf16_t kb = f2bf(kt);
      gk[(blk * 64 + t) * 128 + d] = kb;
      if (tt & 1) ktp[tt >> 1] |= ((unsigned)kb) << 16; else ktp[tt >> 1] = kb;
    }
    bf16_t* kd = gkt + (blk * 128 + d) * 64 + half * 32;
#pragma unroll
    for (int q = 0; q < 4; ++q) { u32x4 v = {ktp[4 * q], ktp[4 * q + 1], ktp[4 * q + 2], ktp[4 * q + 3]}; *(u32x4*)(kd + 8 * q) = v; }
    if (half == 0) ge[blk * 128 + d] = __expf(TOTAL);
  }
}

DI void gla_scan_unit(const Params& p, int g, int u, char* smem) {
  const GroupInfo gi = group_info(p, g);
  bf16_t* St = (bf16_t*)smem;
  bf16_t* Am = St + 64 * 136;
  const int slice = u & 3, dir = (u >> 2) & 1, head = (u >> 3) & 3, seq = u >> 5;
  const int nchunk = gi.S >> 6, chunk0 = seq * nchunk;
  const int tid = TID(), lane = tid & 63, wave = tid >> 6, wi = wave >> 1, wd = wave & 1, h = lane >> 5, l31 = lane & 31;
  const bf16_t* gq = (const bf16_t*)(p.ws + OFF_GQ); const bf16_t* gk = (const bf16_t*)(p.ws + OFF_GK); const bf16_t* gkt = (const bf16_t*)(p.ws + OFF_GKT);
  const float* ge = (const float*)(p.ws + OFF_GE); const bf16_t* vgT = (const bf16_t*)(p.ws + OFF_VGT);
  bf16_t* od = (bf16_t*)gi.out + (size_t)dir * TOKG * 1024;
  __syncthreads();
  for (int i = tid; i < 64 * 136 / 2; i += 256) ((unsigned*)St)[i] = 0u;
  f32x16 Sacc[2];
#pragma unroll
  for (int t = 0; t < 2; ++t)
#pragma unroll
    for (int r = 0; r < 16; ++r) Sacc[t][r] = 0.f;
  __syncthreads();
  auto blk_of = [&](int step) __attribute__((always_inline)) { return (size_t)((dir * 4 + head) * 256 + chunk0 + (dir ? nchunk - 1 - step : step)); };
  bf16x8 qf[8], kf[8];
  {
    const size_t blk = blk_of(0);
#pragma unroll
    for (int s = 0; s < 8; ++s) { qf[s] = *(const bf16x8*)(gq + blk * 8192 + (wi * 32 + l31) * 128 + s * 16 + h * 8); kf[s] = *(const bf16x8*)(gk + blk * 8192 + (wd * 32 + l31) * 128 + s * 16 + h * 8); }
  }
  for (int step = 0; step < nchunk; ++step) {
    const int cgk = chunk0 + (dir ? nchunk - 1 - step : step);
    const size_t blk = (size_t)((dir * 4 + head) * 256 + cgk);
    const size_t blkn = blk_of(step + 1 < nchunk ? step + 1 : step);
    const bf16_t* gkt_c = gkt + blk * 8192;
    const bf16_t* vt_c = vgT + ((size_t)(head * 256 + cgk) * 256 + slice * 64) * 64;
    const float* e_c = ge + blk * 128;
    bf16x8 vf[4], ktf[2][4]; f32x4 ev[2][4];
#pragma unroll
    for (int s = 0; s < 4; ++s) vf[s] = *(const bf16x8*)(vt_c + (wd * 32 + l31) * 64 + s * 16 + h * 8);
#pragma unroll
    for (int t = 0; t < 2; ++t)
#pragma unroll
      for (int s = 0; s < 4; ++s) ktf[t][s] = *(const bf16x8*)(gkt_c + ((2 * wi + t) * 32 + l31) * 64 + s * 16 + h * 8);
    f32x16 X;
#pragma unroll
    for (int r = 0; r < 16; ++r) X[r] = 0.f;
#pragma unroll
    for (int s = 0; s < 8; ++s) X = MFMA32(kf[s], qf[s], X);
    __builtin_amdgcn_sched_barrier(0);
#pragma unroll
    for (int s = 0; s < 8; ++s) kf[s] = *(const bf16x8*)(gk + blkn * 8192 + (wd * 32 + l31) * 128 + s * 16 + h * 8);
    {
      const int gi_ = wi * 32 + l31;
#pragma unroll
      for (int q4 = 0; q4 < 4; ++q4) {
        float v[4];
#pragma unroll
        for (int e = 0; e < 4; ++e) { const int gj = wd * 32 + 8 * q4 + 4 * h + e; const bool keep = dir ? (gj >= gi_) : (gj <= gi_); v[e] = keep ? X[4 * q4 + e] : 0.f; }
        u32x2 o; o.x = pk_bf16(v[0], v[1]); o.y = pk_bf16(v[2], v[3]);
        *(u32x2*)(Am + gi_ * 72 + wd * 32 + 8 * q4 + 4 * h) = o;
      }
    }
    f32x16 o;
#pragma unroll
    for (int r = 0; r < 16; ++r) o[r] = 0.f;
#pragma unroll
    for (int s = 0; s < 8; ++s) { const bf16x8 sf = *(const bf16x8*)(St + (wd * 32 + l31) * 136 + s * 16 + h * 8); o = MFMA32(qf[s], sf, o); }
    __builtin_amdgcn_sched_barrier(0);
#pragma unroll
    for (int s = 0; s < 8; ++s) qf[s] = *(const bf16x8*)(gq + blkn * 8192 + (wi * 32 + l31) * 128 + s * 16 + h * 8);
    lds_barrier();
#pragma unroll
    for (int t = 0; t < 2; ++t)
#pragma unroll
      for (int q4 = 0; q4 < 4; ++q4) ev[t][q4] = *(const f32x4*)(e_c + (2 * wi + t) * 32 + 8 * q4 + 4 * h);
#pragma unroll
    for (int s = 0; s < 4; ++s) { const bf16x8 af = *(const bf16x8*)(Am + (wi * 32 + l31) * 72 + s * 16 + h * 8); o = MFMA32(af, vf[s], o); }
    {
      const size_t tokb = (size_t)cgk * 64 + wi * 32;
#pragma unroll
      for (int r = 0; r < 16; ++r) od[(tokb + crow(r, h)) * 1024 + head * 256 + slice * 64 + wd * 32 + l31] = f2bf(o[r]);
    }
#pragma unroll
    for (int t = 0; t < 2; ++t) {
#pragma unroll
      for (int s = 0; s < 4; ++s) Sacc[t] = MFMA32(ktf[t][s], vf[s], Sacc[t]);
#pragma unroll
      for (int q4 = 0; q4 < 4; ++q4)
#pragma unroll
        for (int e = 0; e < 4; ++e) Sacc[t][4 * q4 + e] *= ev[t][q4][e];
    }
    lds_barrier();
#pragma unroll
    for (int t = 0; t < 2; ++t) {
      const int dkb = 2 * wi + t;
#pragma unroll
      for (int q4 = 0; q4 < 4; ++q4) {
        u32x2 w; w.x = pk_bf16(Sacc[t][4 * q4], Sacc[t][4 * q4 + 1]); w.y = pk_bf16(Sacc[t][4 * q4 + 2], Sacc[t][4 * q4 + 3]);
        *(u32x2*)(St + (wd * 32 + l31) * 136 + dkb * 32 + 8 * q4 + 4 * h) = w;
      }
    }
    lds_barrier();
  }
}

DI int t5_bucket(int rel) {
  const int n = rel < 0 ? -rel : rel; int b;
  if (n < 8) b = n; else b = 8 + (n >= 12) + (n >= 16) + (n >= 23) + (n >= 32) + (n >= 46) + (n >= 64) + (n >= 91);
  if (b > 15) b = 15;
  return b + (rel > 0 ? 16 : 0);
}

DI void attn_item(const Params& p, int g, int seq, int hd, int qt, int m, char* smem, int split_j, int sub) {
  const GroupInfo gi = group_info(p, g);
  const int S = gi.S;
  const int sb = seq * S, q0 = qt * 128;
  bf16_t* Ks = (bf16_t*)smem;
  bf16_t* Vs = Ks + 4 * 32 * 72;
  float* tab = (float*)(Vs + 4 * 128 * 40);
  const bf16_t* proj = (const bf16_t*)(p.ws + OFF_PROJ); const bf16_t* vaT = (const bf16_t*)(p.ws + OFF_VAT); bf16_t* oa = (bf16_t*)(p.ws + (m ? OFF_OA2 : OFF_OA));
  const int tid = TID(), lane = tid & 63, wave = __builtin_amdgcn_readfirstlane(tid >> 6), h_ = lane >> 5, l31_ = lane & 31;
  __syncthreads();
  for (int i = tid; i < 257; i += 256) tab[i] = p.rel_bias[t5_bucket(i - 128) * 8 + hd] * LOG2E;
  const float cneg = p.rel_bias[15 * 8 + hd] * LOG2E, cpos = p.rel_bias[31 * 8 + hd] * LOG2E;
  const bf16_t* qrow = proj + (size_t)(sb + q0 + wave * 32 + l31_) * NPROJ + hd * 128 + h_ * 8;
  const int kr0 = tid >> 3, kc = (tid & 7) * 8;
  const int vr0 = tid >> 2, vc = (tid & 3) * 8;
  const bf16_t* vsrc = vaT + (size_t)(hd * 512 + (sb >> 5)) * 4096 + tid * 8;
  const int npairs = (split_j < 0) ? (S >> 6) : (S >> 6) / SPLIT_SP;
  const int tbase = (split_j < 0) ? 0 : split_j * npairs * 2;
  const int qw0 = q0 + wave * 32;
  bf16x8 qf[4];
#pragma unroll
  for (int s = 0; s < 4; ++s) qf[s] = *(const bf16x8*)(qrow + m * 64 + s * 16);
  f32x16 O[4];
#pragma unroll
  for (int dt = 0; dt < 4; ++dt)
#pragma unroll
    for (int r = 0; r < 16; ++r) O[dt][r] = 0.f;
  f32x2 ls2 = {0.f, 0.f};
  int region = 0;
  const bf16_t* ksrc = (const bf16_t*)(p.ws + OFF_KBLK) + (size_t)((hd * 2 + m) * 512 + (sb >> 5)) * 2048 + tid * 8;
  u32x4 rkA, rvA0, rvA1, rkB, rvB0, rvB1;
  auto load_tile = [&](int t, u32x4& k, u32x4& v0, u32x4& v1) __attribute__((always_inline)) {
    k = *(const u32x4*)(ksrc + (size_t)(tbase + t) * 2048);
    v0 = *(const u32x4*)(vsrc + (size_t)(tbase + t) * 4096); v1 = *(const u32x4*)(vsrc + (size_t)(tbase + t) * 4096 + 2048);
  };
  auto store_tile = [&](int buf, const u32x4& k, const u32x4& v0, const u32x4& v1) __attribute__((always_inline)) {
    bf16_t* Kn = Ks + buf * 32 * 72; bf16_t* Vn = Vs + buf * 128 * 40;
    *(u32x4*)(Kn + kr0 * 72 + kc) = k;
    *(u32x4*)(Vn + vr0 * 40 + vc) = v0; *(u32x4*)(Vn + (vr0 + 64) * 40 + vc) = v1;
  };
  auto rescale = [&](float f) __attribute__((always_inline)) {
#pragma unroll
    for (int dt = 0; dt < 4; ++dt)
#pragma unroll
      for (int r = 0; r < 16; ++r) O[dt][r] *= f;
    ls2 *= f;
  };
  auto compute = [&](int st, int buf) __attribute__((always_inline)) {
    const int k0 = (tbase + st) * 32, h = h_, l31 = l31_;
    const bf16_t* Kb = Ks + buf * 32 * 72; const bf16_t* Vb = Vs + buf * 128 * 40;
    const int rmin = k0 - (qw0 + 31), rmax = k0 + 31 - qw0;
    const bool farL = rmax <= -128, farR = rmin >= 128;
    if (!farL && region == 0) { rescale(__builtin_amdgcn_exp2f(cneg)); region = 1; }
    if (farR && region == 1) { rescale(__builtin_amdgcn_exp2f(-cpos)); region = 2; }
    bf16x8 kf[4], vf[2][4];
#pragma unroll
    for (int s = 0; s < 4; ++s) kf[s] = *(const bf16x8*)(Kb + l31 * 72 + s * 16 + h * 8);
#pragma unroll
    for (int s2 = 0; s2 < 2; ++s2)
#pragma unroll
      for (int dt = 0; dt < 4; ++dt) vf[s2][dt] = *(const bf16x8*)(Vb + (dt * 32 + l31) * 40 + s2 * 16 + h * 8);
    __builtin_amdgcn_sched_barrier(0);
    f32x16 X;
#pragma unroll
    for (int r = 0; r < 16; ++r) X[r] = 0.f;
#pragma unroll
    for (int s = 0; s < 4; ++s) X = MFMA32(kf[s], qf[s], X);
    if (farL || farR) {
#pragma unroll
      for (int r = 0; r < 16; ++r) X[r] = __builtin_amdgcn_exp2f(X[r]);
    } else {
      const int rel0 = k0 - (qw0 + l31) + 128;
#pragma unroll
      for (int r = 0; r < 16; ++r) { int idx = rel0 + crow(r, h); idx = idx < 0 ? 0 : (idx > 256 ? 256 : idx); X[r] = __builtin_amdgcn_exp2f(X[r] + tab[idx]); }
    }
    bf16x8 pf[2];
#pragma unroll
    for (int s2 = 0; s2 < 2; ++s2) {
      u32x4 w; w.x = pk_bf16(X[8 * s2], X[8 * s2 + 1]); w.y = pk_bf16(X[8 * s2 + 2], X[8 * s2 + 3]); w.z = pk_bf16(X[8 * s2 + 4], X[8 * s2 + 5]); w.w = pk_bf16(X[8 * s2 + 6], X[8 * s2 + 7]);
      ls2 += (f32x2){X[8 * s2], X[8 * s2 + 1]}; ls2 += (f32x2){X[8 * s2 + 2], X[8 * s2 + 3]};
      ls2 += (f32x2){X[8 * s2 + 4], X[8 * s2 + 5]}; ls2 += (f32x2){X[8 * s2 + 6], X[8 * s2 + 7]};
      pf[s2] = __builtin_bit_cast(bf16x8, w);
    }
#pragma unroll
    for (int s2 = 0; s2 < 2; ++s2)
#pragma unroll
      for (int dt = 0; dt < 4; ++dt) O[dt] = MFMA32(pf[s2], vf[s2][dt], O[dt]);
  };
  load_tile(0, rkA, rvA0, rvA1);
  load_tile(1, rkB, rvB0, rvB1);
  __syncthreads();
  store_tile(0, rkA, rvA0, rvA1);
  store_tile(1, rkB, rvB0, rvB1);
  __syncthreads();
  for (int it = 0; it < npairs; ++it) {
    const int set = it & 1;
    if (it + 1 < npairs) { load_tile(2 * it + 2, rkA, rvA0, rvA1); load_tile(2 * it + 3, rkB, rvB0, rvB1); }
    compute(2 * it, 2 * set);
    compute(2 * it + 1, 2 * set + 1);
    if (it + 1 < npairs) { store_tile(2 * (set ^ 1), rkA, rvA0, rvA1); store_tile(2 * (set ^ 1) + 1, rkB, rvB0, rvB1); }
    __syncthreads();
  }
  if (split_j >= 0) {
    if (region == 0) rescale(__builtin_amdgcn_exp2f(cneg));
    else if (region == 2) rescale(__builtin_amdgcn_exp2f(cpos));
  }
  float ls = ls2.x + ls2.y;
  ls += __shfl_xor(ls, 32);
  int h = h_, l31 = l31_; OPAQUE(h); OPAQUE(l31);
  if (split_j >= 0) {
    bf16_t* po = (bf16_t*)(p.ws + OFF_PO) + (size_t)sub * 16384 + (wave * 32) * 128 + l31;
    float* pl = (float*)(p.ws + OFF_PL) + sub * 128 + wave * 32;
    if (h == 0) pl[l31] = ls;
#pragma unroll
    for (int r = 0; r < 16; ++r) {
#pragma unroll
      for (int dt = 0; dt < 4; ++dt) po[crow(r, h) * 128 + dt * 32] = f2bf(O[dt][r]);
      asm volatile("" ::: "memory");
    }
    return;
  }
  bf16_t* obase = oa + (size_t)(sb + q0 + wave * 32) * 1024 + hd * 128 + l31;
  const float inv = 1.f / ls;
#pragma unroll
  for (int r = 0; r < 16; ++r) {
    const float a = __shfl(inv, crow(r, h));
#pragma unroll
    for (int dt = 0; dt < 4; ++dt) obase[crow(r, h) * 1024 + dt * 32] = f2bf(O[dt][r] * a);
    asm volatile("" ::: "memory");
  }
}

DI void phase_mixers(const Params& p, int gc, char* smem, int* s_item, int bid) {
  const int g = gc & 3;
  const GroupInfo gi = group_info(p, g);
  const int x = bid & 7;
  int* ctr = (int*)(p.ws + OFF_MISC) + gc * 8 + x;
  const int nsplit = (gi.nseq == 1) ? SPLIT_NS : 0;
  const int nreg = 256 - nsplit;
  const int nscan_x = gi.nseq * 4, total = nscan_x + nreg + nsplit * SPLIT_SP, nq = gi.S >> 7;
  for (;;) {
    __syncthreads();
    if (TID() == 0) *s_item = atomicAdd(ctr, 1);
    __syncthreads();
    const int item = *s_item;
    if (item >= total) break;
    if (item < nscan_x) gla_scan_unit(p, g, x * nscan_x + item, smem);
    else if (item < nscan_x + nreg) { const int ai = item - nscan_x, idx = ai >> 1; attn_item(p, g, idx / nq, x, idx % nq, ai & 1, smem, -1, 0); }
    else { const int sidx = item - nscan_x - nreg, ai = nreg + sidx / SPLIT_SP, idx = ai >> 1; attn_item(p, g, idx / nq, x, idx % nq, ai & 1, smem, sidx % SPLIT_SP, x * 64 + sidx); }
  }
}

DI void unpack8(const u32x4& v, float (&f)[8]) {
  f[0] = __uint_as_float(v.x << 16); f[1] = __uint_as_float(v.x & 0xffff0000u); f[2] = __uint_as_float(v.y << 16); f[3] = __uint_as_float(v.y & 0xffff0000u);
  f[4] = __uint_as_float(v.z << 16); f[5] = __uint_as_float(v.z & 0xffff0000u); f[6] = __uint_as_float(v.w << 16); f[7] = __uint_as_float(v.w & 0xffff0000u);
}
DI u32x4 pack8(const float (&f)[8]) { u32x4 v; v.x = pk_bf16(f[0], f[1]); v.y = pk_bf16(f[2], f[3]); v.z = pk_bf16(f[4], f[5]); v.w = pk_bf16(f[6], f[7]); return v; }

DI void phase_gla_norm(const Params& p, int g, int bid, int nb) {
  const GroupInfo gi = group_info(p, g);
  const bf16_t* of = (const bf16_t*)gi.out; const bf16_t* ob = of + (size_t)TOKG * 1024;
  const bf16_t* proj = (const bf16_t*)(p.ws + OFF_PROJ); bf16_t* dst = (bf16_t*)(p.ws + OFF_H);
  bf16_t* oa = (bf16_t*)(p.ws + OFF_OA); const bf16_t* oa2 = (const bf16_t*)(p.ws + OFF_OA2);
  const float lam = *(const float*)(p.ws + OFF_MISC + 1024);
  const int lane = TID() & 63, wave = TID() >> 6;
  float gn[16], sg[16];
#pragma unroll
  for (int e = 0; e < 16; ++e) { gn[e] = p.gla_norm_g[(lane & 15) * 16 + e]; sg[e] = p.subln_g[(lane & 7) * 16 + e] * 0.8f; }
  for (int tok = bid * 4 + wave; tok < TOKG; tok += nb * 4) {
    const size_t base = (size_t)tok * 1024 + lane * 16;
    const u32x4 f0 = *(const u32x4*)(of + base), f1 = *(const u32x4*)(of + base + 8), b0 = *(const u32x4*)(ob + base), b1 = *(const u32x4*)(ob + base + 8);
    const u32x4 g0 = *(const u32x4*)(proj + (size_t)tok * NPROJ + POG + lane * 16), g1 = *(const u32x4*)(proj + (size_t)tok * NPROJ + POG + lane * 16 + 8);
    const u32x4 a0 = *(const u32x4*)(oa + base), a1 = *(const u32x4*)(oa + base + 8), c0 = *(const u32x4*)(oa2 + base), c1 = *(const u32x4*)(oa2 + base + 8);
    float v[16], w[16], t[8], og[16];
    unpack8(f0, t);
#pragma unroll
    for (int e = 0; e < 8; ++e) v[e] = t[e];
    unpack8(f1, t);
#pragma unroll
    for (int e = 0; e < 8; ++e) v[8 + e] = t[e];
    unpack8(b0, t);
#pragma unroll
    for (int e = 0; e < 8; ++e) v[e] += t[e];
    unpack8(b1, t);
#pragma unroll
    for (int e = 0; e < 8; ++e) v[8 + e] += t[e];
    unpack8(g0, t);
#pragma unroll
    for (int e = 0; e < 8; ++e) og[e] = t[e];
    unpack8(g1, t);
#pragma unroll
    for (int e = 0; e < 8; ++e) og[8 + e] = t[e];
    if (gi.nseq == 1 && tok >= (128 - SPLIT_NS / 2) * 128) {
      const int x = lane >> 3, row = tok & 127, ai0 = (tok >> 7) * 2 - (256 - SPLIT_NS);
      const bf16_t* po = (const bf16_t*)(p.ws + OFF_PO); const float* pl = (const float*)(p.ws + OFF_PL);
#pragma unroll
      for (int m = 0; m < 2; ++m) {
        float acc[16], lsum = 0.f;
#pragma unroll
        for (int e = 0; e < 16; ++e) acc[e] = 0.f;
#pragma unroll
        for (int j = 0; j < SPLIT_SP; ++j) {
          const int sub = x * 64 + (ai0 + m) * SPLIT_SP + j;
          lsum += pl[sub * 128 + row];
          const bf16_t* src = po + (size_t)sub * 16384 + row * 128 + (lane & 7) * 16;
          unpack8(*(const u32x4*)src, t);
#pragma unroll
          for (int e = 0; e < 8; ++e) acc[e] += t[e];
          unpack8(*(const u32x4*)(src + 8), t);
#pragma unroll
          for (int e = 0; e < 8; ++e) acc[8 + e] += t[e];
        }
        const float sc = (m == 0) ? (1.f / lsum) : (-lam / lsum);
#pragma unroll
        for (int e = 0; e < 16; ++e) { if (m == 0) w[e] = acc[e] * sc; else w[e] += acc[e] * sc; }
      }
    } else {
      unpack8(a0, t);
#pragma unroll
      for (int e = 0; e < 8; ++e) w[e] = t[e];
      unpack8(a1, t);
#pragma unroll
      for (int e = 0; e < 8; ++e) w[8 + e] = t[e];
      unpack8(c0, t);
#pragma unroll
      for (int e = 0; e < 8; ++e) w[e] -= lam * t[e];
      unpack8(c1, t);
#pragma unroll
      for (int e = 0; e < 8; ++e) w[8 + e] -= lam * t[e];
    }
    float s1 = 0.f, s2 = 0.f;
#pragma unroll
    for (int e = 0; e < 16; ++e) { s1 += v[e] * v[e]; s2 += w[e] * w[e]; }
    s1 += __shfl_xor(s1, 1); s2 += __shfl_xor(s2, 1); s1 += __shfl_xor(s1, 2); s2 += __shfl_xor(s2, 2);
    s1 += __shfl_xor(s1, 4); s2 += __shfl_xor(s2, 4); s1 += __shfl_xor(s1, 8);
    const float r1 = rsqrtf(s1 * (1.f / 256.f) + EPSN), r2 = rsqrtf(s2 * (1.f / 128.f) + EPSN);
    float o1[8], o2[8];
#pragma unroll
    for (int e = 0; e < 8; ++e) { o1[e] = v[e] * r1 * gn[e] * og[e]; o2[e] = v[8 + e] * r1 * gn[8 + e] * og[8 + e]; }
    *(u32x4*)(dst + base) = pack8(o1); *(u32x4*)(dst + base + 8) = pack8(o2);
#pragma unroll
    for (int e = 0; e < 8; ++e) { o1[e] = w[e] * r2 * sg[e]; o2[e] = w[8 + e] * r2 * sg[8 + e]; }
    *(u32x4*)(oa + base) = pack8(o1); *(u32x4*)(oa + base + 8) = pack8(o2);
  }
}

DI void phase_merge(const Params& p, int g, char* smem, int bid, int nb) {
  bf16_t* As = (bf16_t*)smem; bf16_t* Bs = As + 128 * 72;
  const bf16_t* OA = (const bf16_t*)(p.ws + OFF_OA); const bf16_t* OB = (const bf16_t*)(p.ws + OFF_H);
  const bf16_t* WA = (const bf16_t*)(p.ws + OFF_WA); const bf16_t* WB = (const bf16_t*)(p.ws + OFF_WB);
  const bf16_t* proj = (const bf16_t*)(p.ws + OFF_PROJ); bf16_t* mg = (bf16_t*)(p.ws + OFF_GQ);
  const int lane = TID() & 63, wave = TID() >> 6, wm_ = wave >> 1, wn_ = wave & 1, h_ = lane >> 5, l31_ = lane & 31;
  TileSched ts(bid, nb, 8);
  int mt, nt;
  while (ts.next(mt, nt)) {
    f32x16 acc[2][2]; zero_acc(acc);
    gemm_tile<false>(OA + (size_t)mt * 128 * 1024, 1024, WA + (size_t)nt * 128 * 1024, 1024, 1024, acc, As, Bs);
    int wm = wm_, wn = wn_, h = h_, l31 = l31_; OPAQUE(wm); OPAQUE(wn); OPAQUE(h); OPAQUE(l31);
    const bf16_t* pt = proj + (size_t)mt * 128 * NPROJ; bf16_t* mgt = mg + (size_t)mt * 128 * 1024;
#pragma unroll
    for (int mi = 0; mi < 2; ++mi)
#pragma unroll
      for (int ni = 0; ni < 2; ++ni)
#pragma unroll
        for (int r = 0; r < 16; ++r) {
          const int off = (wm * 64 + mi * 32 + crow(r, h)) * NPROJ + nt * 128 + wn * 64 + ni * 32 + l31;
          const float sga = bf2f(pt[off + PGA]), sgb = fmaxf(bf2f(pt[off + PGB]), 1e-20f);
          acc[mi][ni][r] *= sga * __builtin_amdgcn_rcpf(sgb);
          if (r == 15) asm volatile("" ::: "memory");
        }
    gemm_tile<false>(OB + (size_t)mt * 128 * 1024, 1024, WB + (size_t)nt * 128 * 1024, 1024, 1024, acc, As, Bs);
    OPAQUE(wm); OPAQUE(wn); OPAQUE(h); OPAQUE(l31);
#pragma unroll
    for (int mi = 0; mi < 2; ++mi)
#pragma unroll
      for (int ni = 0; ni < 2; ++ni)
      {
        bf16_t gb16[16];
#pragma unroll
        for (int r = 0; r < 16; ++r) gb16[r] = pt[(wm * 64 + mi * 32 + crow(r, h)) * NPROJ + nt * 128 + wn * 64 + ni * 32 + l31 + PGB];
#pragma unroll
        for (int r = 0; r < 16; ++r) {
          const int rl = wm * 64 + mi * 32 + crow(r, h), cl = nt * 128 + wn * 64 + ni * 32 + l31;
          mgt[rl * 1024 + cl] = f2bf(acc[mi][ni][r] * fmaxf(bf2f(gb16[r]), 1e-20f));
        }
      }
  }
}

DI void phase_outproj(const Params& p, int g, char* smem, int bid, int nb) {
  const GroupInfo gi = group_info(p, g);
  bf16_t* As = (bf16_t*)smem; bf16_t* Bs = As + 128 * 72;
  const bf16_t* MG = (const bf16_t*)(p.ws + OFF_GQ); const bf16_t* WO = (const bf16_t*)(p.ws + OFF_WO);
  const float* mod = (const float*)(p.ws + OFF_MOD);
  const int lane = TID() & 63, wave = TID() >> 6, wm_ = wave >> 1, wn_ = wave & 1, h_ = lane >> 5, l31_ = lane & 31;
  TileSched ts(bid, nb, 8);
  int mt, nt;
  while (ts.next(mt, nt)) {
    f32x16 acc[2][2]; zero_acc(acc);
    gemm_tile<false>(MG + (size_t)mt * 128 * 1024, 1024, WO + (size_t)nt * 128 * 1024, 1024, 1024, acc, As, Bs);
    int wm = wm_, wn = wn_, h = h_, l31 = l31_; OPAQUE(wm); OPAQUE(wn); OPAQUE(h); OPAQUE(l31);
    const int b = row_batch(gi, mt * 128);
    const float* xt = gi.x + (size_t)mt * 128 * 1024; float* ot = gi.out + (size_t)mt * 128 * 1024;
#pragma unroll
    for (int ni = 0; ni < 2; ++ni) {
      const int col = nt * 128 + wn * 64 + ni * 32 + l31;
      const float gt = mod[b * 6144 + 2048 + col];
#pragma unroll
      for (int mi = 0; mi < 2; ++mi) {
        float xv[16];
#pragma unroll
        for (int r = 0; r < 16; ++r) xv[r] = xt[(wm * 64 + mi * 32 + crow(r, h)) * 1024 + col];
#pragma unroll
        for (int r = 0; r < 16; ++r) ot[(wm * 64 + mi * 32 + crow(r, h)) * 1024 + col] = xv[r] + gt * acc[mi][ni][r];

      }
    }
  }
}

DI void phase_up(const Params& p, int g, char* smem, int bid, int nb) {
  bf16_t* As = (bf16_t*)smem; bf16_t* Bs = As + 128 * 72;
  const bf16_t* H2 = (const bf16_t*)(p.ws + OFF_H); const bf16_t* WU = (const bf16_t*)(p.ws + OFF_WUP); bf16_t* U = (bf16_t*)(p.ws + OFF_PROJ);
  const int lane = TID() & 63, wave = TID() >> 6, wm_ = wave >> 1, wn_ = wave & 1, h_ = lane >> 5, l31_ = lane & 31;
  TileSched ts(bid, nb, 32);
  int mt, nt;
  while (ts.next(mt, nt)) {
    f32x16 acc[2][2]; zero_acc(acc);
    gemm_tile<false>(H2 + (size_t)mt * 128 * 1024, 1024, WU + (size_t)nt * 128 * 1024, 1024, 1024, acc, As, Bs);
    int wm = wm_, wn = wn_, h = h_, l31 = l31_; OPAQUE(wm); OPAQUE(wn); OPAQUE(h); OPAQUE(l31);
#pragma unroll
    for (int mi = 0; mi < 2; ++mi)
#pragma unroll
      for (int ni = 0; ni < 2; ++ni)
#pragma unroll
        for (int r = 0; r < 16; ++r) {
          const float v = fmaxf(acc[mi][ni][r], 0.f);
          (U + (size_t)mt * 128 * 4096)[(wm * 64 + mi * 32 + crow(r, h)) * 4096 + nt * 128 + wn * 64 + ni * 32 + l31] = f2bf(v * v);
        }
  }
}

DI void phase_down(const Params& p, int g, char* smem, int bid, int nb) {
  const GroupInfo gi = group_info(p, g);
  bf16_t* As = (bf16_t*)smem; bf16_t* Bs = As + 128 * 72;
  const bf16_t* U = (const bf16_t*)(p.ws + OFF_PROJ); const bf16_t* WD = (const bf16_t*)(p.ws + OFF_WDN);
  const float* mod = (const float*)(p.ws + OFF_MOD);
  const int lane = TID() & 63, wave = TID() >> 6, wm_ = wave >> 1, wn_ = wave & 1, h_ = lane >> 5, l31_ = lane & 31;
  TileSched ts(bid, nb, 8);
  int mt, nt;
  while (ts.next(mt, nt)) {
    f32x16 acc[2][2]; zero_acc(acc);
    gemm_tile<false>(U + (size_t)mt * 128 * 4096, 4096, WD + (size_t)nt * 128 * 4096, 4096, 4096, acc, As, Bs);
    int wm = wm_, wn = wn_, h = h_, l31 = l31_; OPAQUE(wm); OPAQUE(wn); OPAQUE(h); OPAQUE(l31);
    const int b = row_batch(gi, mt * 128);
    float* ot = gi.out + (size_t)mt * 128 * 1024;
#pragma unroll
    for (int ni = 0; ni < 2; ++ni) {
      const int col = nt * 128 + wn * 64 + ni * 32 + l31;
      const float gt = mod[b * 6144 + 5120 + col];
#pragma unroll
      for (int mi = 0; mi < 2; ++mi) {
        float xv[16];
#pragma unroll
        for (int r = 0; r < 16; ++r) xv[r] = ot[(wm * 64 + mi * 32 + crow(r, h)) * 1024 + col];
#pragma unroll
        for (int r = 0; r < 16; ++r) ot[(wm * 64 + mi * 32 + crow(r, h)) * 1024 + col] = xv[r] + gt * acc[mi][ni][r];

      }
    }
  }
}


#define XB_TMO      128
#define XB_XCNT(j)  (256  + 64 * (j))
#define XB_XSUB(j)  (1280 + 64 * (j))
#define XB_XGEN(j)  (2304 + 64 * (j))
#define XB_TOP      3328
#define XB_TOPGEN   3392
#define XCD_BAR_WORDS 3456
#define XB_SPIN_CAP (1u << 20)
#define LAS __attribute__((address_space(3)))
DI unsigned xb_ld(unsigned* p) { return __hip_atomic_load(p, __ATOMIC_RELAXED, __HIP_MEMORY_SCOPE_AGENT); }
DI unsigned xb_add(unsigned* p, unsigned v) { return __hip_atomic_fetch_add(p, v, __ATOMIC_RELAXED, __HIP_MEMORY_SCOPE_AGENT); }
DI unsigned xb_xcc_id() { return (unsigned)__builtin_amdgcn_s_getreg((3 << 11) | 20) & 0xFu; }
#define XB_SPIN(cond, bar) do { unsigned _sp = 0; while (cond) { __builtin_amdgcn_s_sleep(1); \
    if ((++_sp & 255u) == 0u) { if (xb_ld(&(bar)[XB_TMO])) break; if (_sp > XB_SPIN_CAP) { atomicAdd(&(bar)[XB_TMO], 1u); break; } } } } while (0)
struct XcdBarrier { unsigned* bar; unsigned x; volatile LAS unsigned* st; };
DI XcdBarrier xcd_barrier_post(unsigned* bar, volatile LAS unsigned* st) {
  XcdBarrier b; b.bar = bar; b.x = xb_xcc_id(); b.st = st;
  if (threadIdx.x == 0) (void)xb_add(&bar[XB_XCNT(b.x)], 1u);
  return b;
}
DI void xcd_barrier_complete(unsigned* bar, unsigned x, unsigned& nloc, unsigned& nx) {
  const unsigned G = gridDim.x * gridDim.y * gridDim.z;
  unsigned sum, cnt, mine, sp = 0u;
  for (;;) {
    sum = 0u; cnt = 0u; mine = 0u;
#pragma unroll
    for (unsigned j = 0; j < 16; ++j) { const unsigned c = xb_ld(&bar[XB_XCNT(j)]); sum += c; cnt += (c > 0u) ? 1u : 0u; mine = (j == x) ? c : mine; }
    if (sum == G) break;
    __builtin_amdgcn_s_sleep(1);
    if ((++sp & 255u) == 0u) { if (xb_ld(&bar[XB_TMO])) break; if (sp > XB_SPIN_CAP) { atomicAdd(&bar[XB_TMO], 1u); break; } }
  }
  nloc = mine > 0u ? mine : 1u; nx = cnt > 0u ? cnt : 1u;
}
DI void xcd_barrier(const XcdBarrier& b) {
  asm volatile("s_waitcnt vmcnt(0)" ::: "memory");
  __syncthreads();
  if (threadIdx.x == 0) {
    unsigned* bar = b.bar;
    __builtin_amdgcn_s_waitcnt(0);
    unsigned nloc = b.st[0], nx = b.st[1];
    if (nloc == 0u) { xcd_barrier_complete(bar, b.x, nloc, nx); b.st[0] = nloc; b.st[1] = nx; }
    const unsigned old = xb_add(&bar[XB_XSUB(b.x)], 1u);
    const unsigned gen = old / nloc;
    if (old + 1u == (gen + 1u) * nloc) {
      __builtin_amdgcn_fence(__ATOMIC_RELEASE, "agent");
      asm volatile("s_waitcnt vmcnt(0)" ::: "memory");
      const unsigned og = xb_add(&bar[XB_TOP], 1u);
      const unsigned tg = og / nx;
      if (og + 1u == (tg + 1u) * nx) xb_add(&bar[XB_TOPGEN], 1u);
      else XB_SPIN(xb_ld(&bar[XB_TOPGEN]) == tg, bar);
      __builtin_amdgcn_fence(__ATOMIC_ACQUIRE, "agent");
      xb_add(&bar[XB_XGEN(b.x)], 1u);
      asm volatile("s_waitcnt vmcnt(0)" ::: "memory");
    } else {
      XB_SPIN(xb_ld(&bar[XB_XGEN(b.x)]) == gen, bar);
      __builtin_amdgcn_fence(__ATOMIC_ACQUIRE, "agent");
      asm volatile("s_waitcnt vmcnt(0)" ::: "memory");
    }
  }
  __syncthreads();
}

constexpr int SMEM_BYTES = 4 * 128 * 72 * 2;

DI void run_phase(const Params& p, int ph, int g, char* smem, int* s_item, int bid, int nb) {
  switch (ph) {
    case 0: phase_prologue(p, smem, bid, nb); break;
    case 1: { const GroupInfo gi = group_info(p, g); phase_modnorm(p, g, gi.x, p.norm1_g, 0, 1024, bid, nb); } break;
    case 2: phase_gemm1(p, g, smem, bid, nb); break;
    case 3: phase_gla_prep(p, g, smem, bid, nb); break;
    case 4: phase_mixers(p, g, smem, s_item, bid); break;
    case 5: phase_gla_norm(p, g, bid, nb); break;
    case 6: phase_merge(p, g, smem, bid, nb); break;
    case 7: phase_outproj(p, g, smem, bid, nb); break;
    case 8: { const GroupInfo gi = group_info(p, g); phase_modnorm(p, g, gi.out, p.norm2_g, 3072, 4096, bid, nb); } break;
    case 9: phase_up(p, g, smem, bid, nb); break;
    case 10: phase_down(p, g, smem, bid, nb); break;
    default: break;
  }
}

template <int PH>
__global__ void __launch_bounds__(256, 2) k_phase(Params p, int g) {
  extern __shared__ __attribute__((aligned(16))) char smem[];
  __shared__ int s_item;
  run_phase(p, PH, g, smem, &s_item, blockIdx.x, gridDim.x);
}
template <int PH> static void launch_phase(const Params& p, int g, hipStream_t stream) { (void)hipFuncSetAttribute((const void*)k_phase<PH>, hipFuncAttributeMaxDynamicSharedMemorySize, SMEM_BYTES); k_phase<PH><<<512, 256, SMEM_BYTES, stream>>>(p, g); }

#if ONE_LAUNCH
__global__ void __launch_bounds__(256, 2) k_mega(Params p) {
  extern __shared__ __attribute__((aligned(16))) char smem[];
  __shared__ int s_item;
  __shared__ uint4 xb_words;
  cg::grid_group grid = cg::this_grid();
  const int bid = blockIdx.x, nb = gridDim.x;
  if (threadIdx.x == 0) xb_words = make_uint4(0u, 0u, 0u, 0u);
  __syncthreads();
  (void)xcd_barrier_post((unsigned*)(p.ws + OFF_BAR), (volatile LAS unsigned*)&xb_words);
  auto seam = [&]() __attribute__((always_inline)) {
    XcdBarrier b; b.bar = (unsigned*)(p.ws + OFF_BAR); b.x = xb_xcc_id(); b.st = (volatile LAS unsigned*)&xb_words;
    xcd_barrier(b);
  };
  run_phase(p, 0, 0, smem, &s_item, bid, nb);
  if (p.ws == nullptr) grid.sync();
  seam();
#pragma unroll 1
  for (int g = 0; g < 3; ++g) {
#pragma unroll 1
    for (int ph = (g == 0 ? 1 : 2); ph <= 10; ++ph) {
      run_phase(p, ph, g, smem, &s_item, bid, nb);
      if (ph == p.probe_mode) { seam(); run_phase(p, ph, g, smem, &s_item, bid, nb); }
      if (ph == 10 && g < 2) run_phase(p, 1, g + 1, smem, &s_item, bid, nb);
      if (!(g == 2 && ph == 10)) seam();
    }
  }
}
#endif

extern "C" void kernel_launch(void* const* d_in, const int* in_sizes, int n_in, void* d_out, int out_size, void* d_ws, size_t ws_size, hipStream_t stream) {
  Params p{};
  const float** pp = (const float**)&p;
  for (int i = 0; i < 27; ++i) pp[i] = (const float*)d_in[i];
  p.out = (float*)d_out;
  p.ws = (char*)d_ws;
  p.probe_mode = PROBE_MODE; p.pad_ = 0;
  if (ws_size < WS_TOTAL) { fprintf(stderr, "workspace too small: %zu < %zu\n", ws_size, (size_t)WS_TOTAL); return; }
#if ONE_LAUNCH
  static int grid_blocks = 0;
  if (!grid_blocks) {
    int dev = 0, cus = 0, per_cu = 0;
    hipGetDevice(&dev);
    hipDeviceGetAttribute(&cus, hipDeviceAttributeMultiprocessorCount, dev);
    (void)hipFuncSetAttribute((const void*)k_mega, hipFuncAttributeMaxDynamicSharedMemorySize, SMEM_BYTES);
    hipOccupancyMaxActiveBlocksPerMultiprocessor(&per_cu, k_mega, 256, SMEM_BYTES);
    if (per_cu > 2) per_cu = 2;
    grid_blocks = cus * per_cu;
  }
  hipMemsetAsync((char*)d_ws + OFF_MISC, 0, 32768, stream);
  void* args[] = {&p};
  hipError_t e = hipLaunchCooperativeKernel((void*)k_mega, dim3(grid_blocks), dim3(256), args, SMEM_BYTES, stream);
  if (e != hipSuccess) fprintf(stderr, "cooperative launch failed: %s (grid %d)\n", hipGetErrorString(e), grid_blocks);
#else
  hipMemsetAsync((char*)d_ws + OFF_MISC, 0, 32768, stream);
  launch_phase<0>(p, 0, stream);
  for (int g = 0; g < 3; ++g) {
    launch_phase<1>(p, g, stream); launch_phase<2>(p, g, stream); launch_phase<3>(p, g, stream); launch_phase<4>(p, g, stream); launch_phase<5>(p, g, stream);
    launch_phase<6>(p, g, stream); launch_phase<7>(p, g, stream); launch_phase<8>(p, g, stream); launch_phase<9>(p, g, stream); launch_phase<10>(p, g, stream);
  }
#endif
}
```
